# Optimizing an MI355X kernel written in HIP

```python
import math
import jax, jax.numpy as jnp
from jax import lax
import numpy as np

D_MODEL = 4096
BATCH = 8
SEQ = 2048
DEPTH = 4

PLE_DIM = 256
Q_BLOCK = 128

A_HEADS = 16
A_HEAD_DIM = 128
IDX_HEADS = 16
IDX_DIM = 128
IDX_TOPK_MAX = 256
B_HEADS = 8
B_QK_DIM = 256
B_V_DIM = 256
RET_CHUNK = 128
C_GROUPS = 16
C_GROUP_DIM = 128
C_CHUNK = 128
D_HEADS = 16
D_NOPE = 128
D_ROPE = 64
D_V = 128
D_Q_LORA = 1536
D_KV_LORA = 512
ROPE_BASE = 10000.0

A_WIDTH = A_HEADS * A_HEAD_DIM
B_WIDTH = B_HEADS * B_V_DIM
C_WIDTH = C_GROUPS * C_GROUP_DIM
D_WIDTH = D_HEADS * D_V
D_QK = D_NOPE + D_ROPE

EVEN_SPLITS = (A_WIDTH, A_HEAD_DIM, A_HEAD_DIM, IDX_HEADS * IDX_DIM, IDX_DIM, IDX_HEADS, A_WIDTH,
               B_HEADS * B_QK_DIM, B_HEADS * B_QK_DIM, B_WIDTH, B_WIDTH)
EVEN_IN = sum(EVEN_SPLITS)
ODD_SPLITS = (C_WIDTH, C_WIDTH, C_WIDTH, D_Q_LORA, D_KV_LORA, D_ROPE, D_WIDTH)
ODD_IN = sum(ODD_SPLITS)
MIX_EVEN = A_WIDTH + B_WIDTH
MIX_ODD = C_WIDTH + D_WIDTH

kernel_name = "hybrid_dsa_retention_gmlp_mla_trunk"


def _split(z, sizes):
    cuts = [int(c) for c in np.cumsum(sizes)[:-1]]
    return jnp.split(z, cuts, axis=-1)


def rms_norm(x, g, eps=1e-6):
    xf = x.astype(jnp.float32)
    y = xf * lax.rsqrt(jnp.mean(xf * xf, axis=-1, keepdims=True) + eps)
    return (y * g.astype(jnp.float32)).astype(x.dtype)


def layer_norm(x, g, eps=1e-6):
    xf = x.astype(jnp.float32)
    xc = xf - jnp.mean(xf, axis=-1, keepdims=True)
    y = xc * lax.rsqrt(jnp.mean(xc * xc, axis=-1, keepdims=True) + eps)
    return (y * g.astype(jnp.float32)).astype(x.dtype)


def _to_blocks(a, nb):
    return jnp.moveaxis(a.reshape((a.shape[0], nb, Q_BLOCK) + a.shape[2:]), 1, 0)


def _from_blocks(a):
    a = jnp.moveaxis(a, 0, 1)
    return a.reshape(a.shape[0], a.shape[1] * a.shape[2], -1)


def dsa_attention(q, k, v, iq, ik, iw, pos):
    Bn, S = q.shape[0], q.shape[1]
    topk = min(IDX_TOPK_MAX, S // 4)
    nb = S // Q_BLOCK
    slopes = jnp.asarray(2.0 ** (-8.0 * np.arange(1, A_HEADS + 1) / A_HEADS), dtype=jnp.float32)
    t_blocks = jnp.arange(S, dtype=jnp.int32).reshape(nb, Q_BLOCK)
    key_idx = jnp.arange(S, dtype=jnp.int32)
    b_idx = jnp.arange(Bn)[:, None, None]
    scale = A_HEAD_DIM ** -0.5
    iscale = IDX_DIM ** -0.5
    wscale = IDX_HEADS ** -0.5

    def one_block(args):
        qb, iqb, iwb, posb, tb = args
        rel = jax.nn.relu(jnp.einsum('bqhd,bsd->bqhs', iqb, ik) * iscale)
        score = jnp.einsum('bqhs,bqh->bqs', rel, iwb * wscale).astype(jnp.float32)
        causal = key_idx[None, :] <= tb[:, None]
        score = jnp.where(causal[None], score, -jnp.inf)
        _, sel = lax.top_k(score, topk)
        ks = k[b_idx, sel]
        vs = v[b_idx, sel]
        ps = pos[b_idx, sel]
        valid = sel <= tb[None, :, None]
        logits = jnp.einsum('bqhd,bqkd->bhqk', qb, ks).astype(jnp.float32) * scale
        dist = (posb[:, :, None] - ps).astype(jnp.float32)
        logits = logits - slopes[None, :, None, None] * dist[:, None]
        logits = jnp.where(valid[:, None], logits, -jnp.inf)
        probs = jax.nn.softmax(logits, axis=-1).astype(v.dtype)
        return jnp.einsum('bhqk,bqkd->bqhd', probs, vs)

    out = lax.map(one_block, (_to_blocks(q, nb), _to_blocks(iq, nb), _to_blocks(iw, nb),
                              _to_blocks(pos, nb), t_blocks))
    return _from_blocks(out)


def retention(q, k, v, gn_gain):
    Bn, S, H, DK = q.shape
    DV = v.shape[-1]
    nc = S // RET_CHUNK
    dt = q.dtype
    log_gamma = jnp.log1p(-(2.0 ** (-5.0 - jnp.arange(H, dtype=jnp.float32))))
    n = jnp.arange(RET_CHUNK, dtype=jnp.float32)
    diff = n[:, None] - n[None, :]
    inner_decay = jnp.where(diff[None] >= 0,
                            jnp.exp(log_gamma[:, None, None] * jnp.maximum(diff, 0.0)[None]), 0.0)
    q_decay = jnp.exp(log_gamma[None, :] * (n[:, None] + 1.0))
    k_decay = jnp.exp(log_gamma[None, :] * (RET_CHUNK - 1.0 - n[:, None]))
    chunk_decay = jnp.exp(log_gamma * RET_CHUNK)
    k = k * (DK ** -0.5)

    def chunks(a):
        return jnp.moveaxis(a.reshape((Bn, nc, RET_CHUNK) + a.shape[2:]), 1, 0)

    def step(state, inp):
        qc, kc, vc = inp
        attn = jnp.einsum('bihd,bjhd->bhij', qc, kc) * inner_decay.astype(dt)[None]
        inner = jnp.einsum('bhij,bjhe->bihe', attn, vc)
        cross = jnp.einsum('bihd,bhde->bihe', qc, state.astype(dt)) * q_decay.astype(dt)[None, :, :, None]
        kv = jnp.einsum('bjhd,bjhe->bhde', kc * k_decay.astype(dt)[None, :, :, None], vc)
        state = state * chunk_decay[None, :, None, None] + kv.astype(jnp.float32)
        return state, inner + cross

    state0 = jnp.zeros((Bn, H, DK, DV), jnp.float32)
    _, out = lax.scan(step, state0, (chunks(q), chunks(k), chunks(v)))
    out = jnp.moveaxis(out, 0, 1).reshape(Bn, S, H, DV)
    out = layer_norm(out, gn_gain)
    return out.reshape(Bn, S, H * DV)


def chunked_spatial_gating(u, v, w_s, b_s, v_gain):
    Bn, S, _ = u.shape
    nc = S // C_CHUNK
    u = jax.nn.gelu(u)
    v = layer_norm(jax.nn.gelu(v), v_gain)
    vg = v.reshape(Bn, nc, C_CHUNK, C_GROUPS, C_GROUP_DIM)
    causal = jnp.tril(jnp.ones((C_CHUNK, C_CHUNK), dtype=bool))
    w = jnp.where(causal[None], w_s, jnp.zeros_like(w_s)).astype(v.dtype)
    mixed = jnp.einsum('gts,bnsgc->bntgc', w, vg) + jnp.swapaxes(b_s, 0, 1).astype(v.dtype)[None, None, :, :, None]
    return (u.reshape(vg.shape) * mixed).reshape(Bn, S, C_WIDTH)


def rope(x, pos):
    half = x.shape[-1] // 2
    inv = ROPE_BASE ** (-jnp.arange(half, dtype=jnp.float32) / half)
    ang = pos.astype(jnp.float32)[..., None] * inv
    cos = jnp.cos(ang)[:, :, None, :]
    sin = jnp.sin(ang)[:, :, None, :]
    x1 = x[..., :half].astype(jnp.float32)
    x2 = x[..., half:].astype(jnp.float32)
    return jnp.concatenate([x1 * cos - x2 * sin, x1 * sin + x2 * cos], axis=-1).astype(x.dtype)


def causal_block_attention(q, k, v, scale):
    S = q.shape[1]
    nb = S // Q_BLOCK
    t_blocks = jnp.arange(S, dtype=jnp.int32).reshape(nb, Q_BLOCK)
    key_idx = jnp.arange(S, dtype=jnp.int32)

    def one_block(args):
        qb, tb = args
        logits = jnp.einsum('bqhd,bshd->bhqs', qb, k).astype(jnp.float32) * scale
        mask = key_idx[None, :] <= tb[:, None]
        logits = jnp.where(mask[None, None], logits, -jnp.inf)
        probs = jax.nn.softmax(logits, axis=-1).astype(v.dtype)
        return jnp.einsum('bhqs,bshe->bqhe', probs, v)

    out = lax.map(one_block, (_to_blocks(q, nb), t_blocks))
    return _from_blocks(out)


def mla_attention(cq, ckv, krope, pos, q_lora_g, kv_lora_g, w_uq, w_ukv, qn_g, kn_g):
    Bn, S, _ = cq.shape
    q = (rms_norm(cq, q_lora_g) @ w_uq).reshape(Bn, S, D_HEADS, D_QK)
    kv = (rms_norm(ckv, kv_lora_g) @ w_ukv).reshape(Bn, S, D_HEADS, D_NOPE + D_V)
    k_nope, v = kv[..., :D_NOPE], kv[..., D_NOPE:]
    k = jnp.concatenate([k_nope, jnp.broadcast_to(krope[:, :, None, :], (Bn, S, D_HEADS, D_ROPE))], axis=-1)
    q = rms_norm(q, qn_g)
    k = rms_norm(k, kn_g)
    q = jnp.concatenate([q[..., :D_NOPE], rope(q[..., D_NOPE:], pos)], axis=-1)
    k = jnp.concatenate([k[..., :D_NOPE], rope(k[..., D_NOPE:], pos)], axis=-1)
    return causal_block_attention(q, k, v, D_QK ** -0.5)


def even_mixer(h, pos, w_in, a_qn, a_kn, b_gn, w_out):
    Bn, S, _ = h.shape
    z = h @ w_in
    qa, ka, va, iq, ik, iw, ga, qb, kb, vb, gb = _split(z, EVEN_SPLITS)
    qa = rms_norm(qa.reshape(Bn, S, A_HEADS, A_HEAD_DIM), a_qn)
    ka = rms_norm(ka, a_kn)
    a_out = dsa_attention(qa, ka, va, iq.reshape(Bn, S, IDX_HEADS, IDX_DIM), ik, iw, pos) * jax.nn.silu(ga)
    b_out = retention(qb.reshape(Bn, S, B_HEADS, B_QK_DIM), kb.reshape(Bn, S, B_HEADS, B_QK_DIM),
                      vb.reshape(Bn, S, B_HEADS, B_V_DIM), b_gn) * jax.nn.silu(gb)
    return jnp.concatenate([a_out, b_out], axis=-1) @ w_out


def odd_mixer(h, pos, w_in, c_vn, c_ws, c_bs, d_qlg, d_kvlg, d_wuq, d_wukv, d_qn, d_kn, w_out):
    z = h @ w_in
    cu, cv, gc, cq, ckv, krope, gd = _split(z, ODD_SPLITS)
    c_out = chunked_spatial_gating(cu, cv, c_ws, c_bs, c_vn) * jax.nn.silu(gc)
    d_out = mla_attention(cq, ckv, krope, pos, d_qlg, d_kvlg, d_wuq, d_wukv, d_qn, d_kn) * jax.nn.silu(gd)
    return jnp.concatenate([c_out, d_out], axis=-1) @ w_out


def setup_inputs(seed: int = 0) -> dict:
    key = jax.random.key(seed)
    ks = iter(jax.random.split(key, 32))
    n_even = (DEPTH + 1) // 2
    n_odd = DEPTH // 2
    f32 = jnp.float32

    def nrm(shape, scale):
        return jax.random.normal(next(ks), shape, f32) * scale

    def gain(shape, noise=0.02):
        return 1.0 + nrm(shape, noise)

    x = nrm((BATCH, SEQ, D_MODEL), 1.0)
    p = nrm((DEPTH, BATCH, SEQ, PLE_DIM), 1.0)
    offsets = jax.random.randint(next(ks), (BATCH, 1), 0, 4096, dtype=jnp.int32)
    positions = offsets + jnp.arange(SEQ, dtype=jnp.int32)[None, :]
    return {
        "x": x,
        "p": p,
        "positions": positions,
        "norm_in": gain((DEPTH, D_MODEL)),
        "even_w_in": nrm((n_even, D_MODEL, EVEN_IN), D_MODEL ** -0.5),
        "even_a_q_norm": gain((n_even, A_HEAD_DIM)),
        "even_a_k_norm": gain((n_even, A_HEAD_DIM)),
        "even_b_group_norm": gain((n_even, B_HEADS, B_V_DIM)),
        "even_w_out": nrm((n_even, MIX_EVEN, D_MODEL), MIX_EVEN ** -0.5),
        "odd_w_in": nrm((n_odd, D_MODEL, ODD_IN), D_MODEL ** -0.5),
        "odd_c_v_norm": gain((n_odd, C_WIDTH)),
        "odd_c_w_s": nrm((n_odd, C_GROUPS, C_CHUNK, C_CHUNK), 0.5 * C_CHUNK ** -0.5),
        "odd_c_b_s": gain((n_odd, C_GROUPS, C_CHUNK), 0.1),
        "odd_d_q_lora_norm": gain((n_odd, D_Q_LORA)),
        "odd_d_kv_lora_norm": gain((n_odd, D_KV_LORA)),
        "odd_d_w_uq": nrm((n_odd, D_Q_LORA, D_HEADS * D_QK), D_Q_LORA ** -0.5),
        "odd_d_w_ukv": nrm((n_odd, D_KV_LORA, D_HEADS * (D_NOPE + D_V)), D_KV_LORA ** -0.5),
        "odd_d_q_norm": gain((n_odd, D_QK)),
        "odd_d_k_norm": gain((n_odd, D_QK)),
        "odd_w_out": nrm((n_odd, MIX_ODD, D_MODEL), MIX_ODD ** -0.5),
        "ple_w_in": nrm((DEPTH, PLE_DIM, D_MODEL), PLE_DIM ** -0.5),
        "ple_w_gate": nrm((DEPTH, D_MODEL, D_MODEL), D_MODEL ** -0.5),
    }


def reference(x, p, positions, norm_in, even_w_in, even_a_q_norm, even_a_k_norm, even_b_group_norm,
              even_w_out, odd_w_in, odd_c_v_norm, odd_c_w_s, odd_c_b_s, odd_d_q_lora_norm,
              odd_d_kv_lora_norm, odd_d_w_uq, odd_d_w_ukv, odd_d_q_norm, odd_d_k_norm, odd_w_out,
              ple_w_in, ple_w_gate):
    for i in range(DEPTH):
        j = i // 2
        h = rms_norm(x, norm_in[i])
        if i % 2 == 0:
            y = even_mixer(h, positions, even_w_in[j], even_a_q_norm[j], even_a_k_norm[j],
                           even_b_group_norm[j], even_w_out[j])
        else:
            y = odd_mixer(h, positions, odd_w_in[j], odd_c_v_norm[j], odd_c_w_s[j], odd_c_b_s[j],
                          odd_d_q_lora_norm[j], odd_d_kv_lora_norm[j], odd_d_w_uq[j], odd_d_w_ukv[j],
                          odd_d_q_norm[j], odd_d_k_norm[j], odd_w_out[j])
        x = x + y
        x = x + (p[i] @ ple_w_in[i]) * jax.nn.sigmoid(x @ ple_w_gate[i])
    return x
```

```cpp
#include <hip/hip_runtime.h>
#include <cstdio>
#include <cstdint>

#ifndef MK_MULTI
#define MK_MULTI 0
#endif

namespace pg8 {
#define PG8_LAS __attribute__((address_space(3)))
__device__ __forceinline__ int hw_lane() { unsigned z = 0u; asm volatile("" : "+v"(z));     return (int)__builtin_amdgcn_mbcnt_hi(~0u, __builtin_amdgcn_mbcnt_lo(~0u, z)); }
typedef unsigned short bf16_t;
typedef short bf16x8 __attribute__((ext_vector_type(8)));
typedef float f32x4 __attribute__((ext_vector_type(4)));
typedef float f32x2 __attribute__((ext_vector_type(2)));
typedef unsigned u32x4 __attribute__((ext_vector_type(4)));
typedef unsigned u32x2 __attribute__((ext_vector_type(2)));
typedef __bf16 nbf16x2 __attribute__((ext_vector_type(2)));
constexpr int BM = 256, BK = 64, HALF = 128, HTB = HALF * BK * 2  , STAGE_BYTES = 8 * HTB, NXCD = 8, WGM = 8;

__host__ __device__ __forceinline__ int lds_byte(int r, int c) { const int st = (r >> 4) * 2 + (c >> 5), rr = r & 15, cc = c & 31, ob = rr * 64 + cc * 2; return st * 1024 + (ob ^ (((ob >> 9) & 1) << 5)); }
__host__ __device__ __forceinline__ void stage_rc(int b, int& R, int& C) { const int st = b / 1024, sb = b % 1024, swz = sb ^ (((sb >> 9) & 1) << 5); R = (st >> 1) * 16 + swz / 64; C = (st & 1) * 32 + (swz % 64) / 2; }
__host__ __device__ __forceinline__ int perm32(int rho) { const int n = rho >> 4, i = rho & 15; return 8 * (i >> 2) + 4 * n + (i & 3); }

struct Unit { int pm, pn; };
struct Gemm { const void* A; const void* Bt; int M, N, Kb, ldab; };
typedef int i32x8 __attribute__((ext_vector_type(8)));
typedef int i32x4 __attribute__((ext_vector_type(4)));
__device__ __forceinline__ i32x8 cat_f8(bf16x8 lo, bf16x8 hi) { const i32x4 a = __builtin_bit_cast(i32x4, lo), b = __builtin_bit_cast(i32x4, hi); return __builtin_shufflevector(a, b, 0, 1, 2, 3, 4, 5, 6, 7); }

struct StaticOrder {
    int nM, nN, nwg, G, c;
    __host__ __device__ void init(int M, int N, int G_, int c_) { nM = M / BM; nN = N / BM; nwg = nM * nN; G = G_; c = c_; }
    __host__ __device__ bool next(int i, Unit& u) const {
        const long L = (long)i * G + c; if (L >= nwg) return false;
        int wgid = (int)L; { const int q = nwg / NXCD, r = nwg % NXCD, xcd = wgid % NXCD, off = wgid / NXCD; wgid = (xcd < r ? xcd * (q + 1) : r * (q + 1) + (xcd - r) * q) + off; }
        const int nig = WGM * nN, gid = wgid / nig, fm = gid * WGM, gsz = (nM - fm) < WGM ? (nM - fm) : WGM;
        u.pm = fm + ((wgid % nig) % gsz); u.pn = (wgid % nig) / gsz; return true;
    }
    __device__ __forceinline__ void a_ready(const Unit&) const {}
    __device__ __forceinline__ void done(const Unit&) const {}
};

__device__ __forceinline__ unsigned cvt_pk_bf16(float lo, float hi) { const f32x2 v = {lo, hi}; const nbf16x2 b = __builtin_convertvector(v, nbf16x2); return __builtin_bit_cast(unsigned, b); }
__device__ __forceinline__ float clamp_f8(float x) { return __builtin_amdgcn_fmed3f(x, -448.0f, 448.0f); }
__device__ __forceinline__ unsigned cvt_pk4_fp8(float a, float b, float c, float d) { a = clamp_f8(a); b = clamp_f8(b); c = clamp_f8(c); d = clamp_f8(d); int w = 0; w = __builtin_amdgcn_cvt_pk_fp8_f32(a, b, w, false); w = __builtin_amdgcn_cvt_pk_fp8_f32(c, d, w, true); return (unsigned)w; }
__device__ __forceinline__ float fast_sigmoid(float a) { return __builtin_amdgcn_rcpf(1.0f + __builtin_amdgcn_exp2f(-1.4426950408889634f * a)); }

__device__ __forceinline__ float xsum16g(float v) { unsigned a = __float_as_uint(v), b = a; asm volatile("" : "+v"(b)); const u32x2 r = __builtin_amdgcn_permlane16_swap(a, b, false, false); return __uint_as_float(r.x) + __uint_as_float(r.y); }
__device__ __forceinline__ float xsum32g(float v) { unsigned a = __float_as_uint(v), b = a; asm volatile("" : "+v"(b)); const u32x2 r = __builtin_amdgcn_permlane32_swap(a, b, false, false); return __uint_as_float(r.x) + __uint_as_float(r.y); }
struct SkewOrder : StaticOrder {
    int nfull;
    __host__ __device__ void init2(int M, int N, int G_, int c_) { init(M, N, G_, c_); nfull = (nwg / G_) - 1; if (nfull < 0 || (nwg % G_) != 0 || (G_ & 1)) nfull = -1; }
    __host__ __device__ bool next(int i, Unit& u) const {
        if (nfull < 0) return StaticOrder::next(i, u);
        long L;
        if (i < nfull) L = (long)i * G + c;
        else { const int k = i - nfull; if (c < G / 2 || k >= 2) return false; L = (long)nfull * G + (long)(c - G / 2) * 2 + k; }
        if (L >= nwg) return false;
        int wgid = (int)L; { const int q = nwg / NXCD, r = nwg % NXCD, xcd = wgid % NXCD, off = wgid / NXCD; wgid = (xcd < r ? xcd * (q + 1) : r * (q + 1) + (xcd - r) * q) + off; }
        const int nig = WGM * nN, gid = wgid / nig, fm = gid * WGM, gsz = (nM - fm) < WGM ? (nM - fm) : WGM;
        u.pm = fm + ((wgid % nig) % gsz); u.pn = (wgid % nig) / gsz; return true;
    }
};
struct EpiBf16 {
    static constexpr bool PERM = true, AFTER_DRAIN = false;
    bf16_t* O; int ldc; float sc; const float* rs;
    __device__ __forceinline__ void operator()(const f32x4 (&acc)[2][2][4][2], const Unit& u, int wr, int wc, int fr_in, int fq) const {
        int fr = fr_in; asm volatile("" : "+v"(fr));
        const int row0 = u.pm * BM + wr * 64 + fr; const int col0 = u.pn * BM + wc * 32 + 8 * fq;
        float s2a[2][4];
        if (rs) { float r[8];
#pragma unroll
            for (int i = 0; i < 8; ++i) r[i] = rs[row0 + (i >> 2) * HALF + (i & 3) * 16];
            asm volatile("" : "+v"(r[0]), "+v"(r[1]), "+v"(r[2]), "+v"(r[3]), "+v"(r[4]), "+v"(r[5]), "+v"(r[6]), "+v"(r[7]));
#pragma unroll
            for (int i = 0; i < 8; ++i) s2a[i >> 2][i & 3] = sc * r[i]; }
        else {
#pragma unroll
            for (int i = 0; i < 8; ++i) s2a[i >> 2][i & 3] = sc; }
#pragma unroll
        for (int ai = 0; ai < 2; ++ai)
#pragma unroll
            for (int m = 0; m < 4; ++m) { bf16_t* rowp = O + (size_t)(row0 + ai * HALF + m * 16) * ldc + col0; const float s2 = s2a[ai][m];
#pragma unroll
                for (int bj = 0; bj < 2; ++bj) { const f32x4 v0 = acc[ai][bj][m][0] * s2, v1 = acc[ai][bj][m][1] * s2;
                    u32x4 w; w.x = cvt_pk_bf16(v0[0], v0[1]); w.y = cvt_pk_bf16(v0[2], v0[3]); w.z = cvt_pk_bf16(v1[0], v1[1]); w.w = cvt_pk_bf16(v1[2], v1[3]);
                    *(u32x4*)(rowp + bj * HALF) = w; } }
    }
};
__device__ __forceinline__ void unpack8(const u32x4 w, float (&v)[8]) {
#pragma unroll
    for (int e = 0; e < 4; ++e) { v[2 * e] = __uint_as_float(w[e] << 16); v[2 * e + 1] = __uint_as_float(w[e] & 0xffff0000u); } }
#define PG8_EOFF(g) ((size_t)(row0 + ((g) >> 2) * HALF + ((g) & 3) * 16) * ldc + col0)
struct EpiResid {
    static constexpr bool PERM = true, AFTER_DRAIN = false;
    const bf16_t* xin; bf16_t* xh; unsigned char* x8; int ldc; float sc;
    __device__ __forceinline__ void operator()(const f32x4 (&acc)[2][2][4][2], const Unit& u, int wr, int wc, int fr_in, int fq) const {
        int fr = fr_in; asm volatile("" : "+v"(fr));
        const int row0 = u.pm * BM + wr * 64 + fr, col0 = u.pn * BM + wc * 32 + 8 * fq;
        constexpr int D = 8; u32x4 buf[D][2];
#pragma unroll
        for (int g = 0; g < D; ++g)
#pragma unroll
            for (int bj = 0; bj < 2; ++bj) buf[g][bj] = *(const u32x4*)(xin + PG8_EOFF(g) + bj * HALF);
#pragma unroll
        for (int g = 0; g < 8; ++g) { const int ai = g >> 2, m = g & 3; const size_t off = PG8_EOFF(g);
#pragma unroll
            for (int bj = 0; bj < 2; ++bj) { const size_t o2 = off + bj * HALF; float bs[8], o[8]; unpack8(buf[g % D][bj], bs);
#pragma unroll
                for (int e = 0; e < 4; ++e) { o[e] = bs[e] + acc[ai][bj][m][0][e] * sc; o[4 + e] = bs[4 + e] + acc[ai][bj][m][1][e] * sc; }
                u32x4 w; w.x = cvt_pk_bf16(o[0], o[1]); w.y = cvt_pk_bf16(o[2], o[3]); w.z = cvt_pk_bf16(o[4], o[5]); w.w = cvt_pk_bf16(o[6], o[7]); *(u32x4*)(xh + o2) = w;
                u32x2 w8; w8.x = cvt_pk4_fp8(o[0], o[1], o[2], o[3]); w8.y = cvt_pk4_fp8(o[4], o[5], o[6], o[7]); *(u32x2*)(x8 + o2) = w8; }
            if (g + D < 8) {
#pragma unroll
                for (int bj = 0; bj < 2; ++bj) buf[g % D][bj] = *(const u32x4*)(xin + PG8_EOFF(g + D) + bj * HALF); }
            asm volatile("" ::: "memory"); }
    }
};
struct EpiGate {
    static constexpr bool PERM = true, AFTER_DRAIN = false;
    bf16_t* xh; const bf16_t* pe; float* out32; unsigned char* x8; float* ps; int ldc; float sc;
    __device__ __forceinline__ void operator()(const f32x4 (&acc)[2][2][4][2], const Unit& u, int wr, int wc, int fr_in, int fq) const {
        int fr = fr_in; asm volatile("" : "+v"(fr));
        const int row0 = u.pm * BM + wr * 64 + fr, col0 = u.pn * BM + wc * 32 + 8 * fq;
        const float sg = -1.4426950408889634f * sc;
        constexpr int D = 4; u32x4 bx[D][2], bp[D][2];
#pragma unroll
        for (int g = 0; g < D; ++g)
#pragma unroll
            for (int bj = 0; bj < 2; ++bj) { bx[g][bj] = *(const u32x4*)(xh + PG8_EOFF(g) + bj * HALF); bp[g][bj] = *(const u32x4*)(pe + PG8_EOFF(g) + bj * HALF); }
#pragma unroll
        for (int g = 0; g < 8; ++g) { const int ai = g >> 2, m = g & 3; const size_t off = PG8_EOFF(g); float ssq = 0.f;
#pragma unroll
            for (int bj = 0; bj < 2; ++bj) { const size_t o2 = off + bj * HALF; float xv[8], pv[8], o[8];
                unpack8(bx[g % D][bj], xv); unpack8(bp[g % D][bj], pv);
#pragma unroll
                for (int e = 0; e < 4; ++e) { o[e] = xv[e] + pv[e] * __builtin_amdgcn_rcpf(1.0f + __builtin_amdgcn_exp2f(acc[ai][bj][m][0][e] * sg)); o[4 + e] = xv[4 + e] + pv[4 + e] * __builtin_amdgcn_rcpf(1.0f + __builtin_amdgcn_exp2f(acc[ai][bj][m][1][e] * sg)); }
                if (out32) { *(f32x4*)(out32 + o2) = (f32x4){o[0], o[1], o[2], o[3]}; *(f32x4*)(out32 + o2 + 4) = (f32x4){o[4], o[5], o[6], o[7]}; }
                else { u32x4 w; w.x = cvt_pk_bf16(o[0], o[1]); w.y = cvt_pk_bf16(o[2], o[3]); w.z = cvt_pk_bf16(o[4], o[5]); w.w = cvt_pk_bf16(o[6], o[7]); *(u32x4*)(xh + o2) = w;
                       u32x2 w8; w8.x = cvt_pk4_fp8(o[0], o[1], o[2], o[3]); w8.y = cvt_pk4_fp8(o[4], o[5], o[6], o[7]); *(u32x2*)(x8 + o2) = w8;
#pragma unroll
                       for (int e = 0; e < 8; ++e) ssq += o[e] * o[e]; } }
            if (!out32) { ssq = xsum32g(xsum16g(ssq)); if (fq == 0) ps[(size_t)(row0 + ai * HALF + m * 16) * 64 + u.pn * 4 + wc] = ssq; }
            if (g + D < 8) {
#pragma unroll
                for (int bj = 0; bj < 2; ++bj) { bx[g % D][bj] = *(const u32x4*)(xh + PG8_EOFF(g + D) + bj * HALF); bp[g % D][bj] = *(const u32x4*)(pe + PG8_EOFF(g + D) + bj * HALF); } }
            asm volatile("" ::: "memory"); }
    }
};
#undef PG8_EOFF

template <class Epi, class Sched, bool ALIGN_EPI = false, bool SP2 = false, bool F8 = false>
__device__ __forceinline__ void gemm_phase(PG8_LAS unsigned char* lds, const Gemm g, const Sched S, const Epi E, const int w0) {
    int tid_ = (w0 << 6) | hw_lane(); asm volatile("" : "+v"(tid_));
    const int tid = tid_, wid = __builtin_amdgcn_readfirstlane(tid >> 6), lane = tid & 63, wr = wid >> 2, wc = wid & 3, fr = lane & 15, fq = lane >> 4;
    const int Kb = g.Kb, nt = Kb / (2 * BK), ldab = g.ldab;
    unsigned voffA[2], voffB[2];
#pragma unroll
    for (int i = 0; i < 2; ++i) { int R, C; stage_rc(tid * 16 + i * 8192, R, C); const int Rb = Epi::PERM ? ((R & ~31) + perm32(R & 31)) : R;
        voffA[i] = (unsigned)(R * ldab + C * 2); voffB[i] = (unsigned)(Rb * Kb + C * 2); }
    const size_t kstep = (size_t)(BK * 2);
    const size_t hstep = (size_t)HALF * Kb;
    const size_t tstep = 2 * hstep; const size_t hstepA = (size_t)HALF * ldab, tstepA = 2 * hstepA;
    const unsigned ldsw = (unsigned)wid * 1024u;
    const int aoff = lds_byte(wr * 64 + fr, fq * 8), boff = lds_byte(wc * 32 + fr, fq * 8);
#define PG8_SA(b, h) (((b) * 2 + (h)) * HTB)
#define PG8_SB(b, h) ((4 + (b) * 2 + (h)) * HTB)
#define PG8_STAGE(bufoff, gbase, voff) do { _Pragma("unroll") for (int _i = 0; _i < 2; ++_i) \
        __builtin_amdgcn_global_load_lds((const unsigned*)((const char*)(gbase) + (voff)[_i]), (PG8_LAS unsigned*)(lds + (bufoff) + ldsw + _i * 8192), 16, 0, 0); } while (0)
#define PG8_LDA(dst, b, h) do { _Pragma("unroll") for (int m = 0; m < 4; ++m) { if constexpr (F8) dst##8[m] = cat_f8(*(const PG8_LAS bf16x8*)(lds + PG8_SA(b, h) + aoff + m * 2048), *(const PG8_LAS bf16x8*)(lds + PG8_SA(b, h) + aoff + m * 2048 + 1024)); \
        else { _Pragma("unroll") for (int k = 0; k < 2; ++k) dst[m][k] = *(const PG8_LAS bf16x8*)(lds + PG8_SA(b, h) + aoff + m * 2048 + k * 1024); } } } while (0)
#define PG8_LDB(dst, b, h) do { _Pragma("unroll") for (int n = 0; n < 2; ++n) { if constexpr (F8) dst##8[n] = cat_f8(*(const PG8_LAS bf16x8*)(lds + PG8_SB(b, h) + boff + n * 2048), *(const PG8_LAS bf16x8*)(lds + PG8_SB(b, h) + boff + n * 2048 + 1024)); \
        else { _Pragma("unroll") for (int k = 0; k < 2; ++k) dst[n][k] = *(const PG8_LAS bf16x8*)(lds + PG8_SB(b, h) + boff + n * 2048 + k * 1024); } } } while (0)
#define PG8_MMA(ai, bj, At, Bt) do { __builtin_amdgcn_s_setprio(1); _Pragma("unroll") for (int m = 0; m < 4; ++m) _Pragma("unroll") for (int n = 0; n < 2; ++n) { \
        if constexpr (F8) asm volatile("v_mfma_f32_16x16x128_f8f6f4 %0, %1, %2, %0" : "+v"(acc[ai][bj][m][n]) : "v"(Bt##8[n]), "v"(At##8[m]));   \
        else { _Pragma("unroll") for (int k = 0; k < 2; ++k) acc[ai][bj][m][n] = __builtin_amdgcn_mfma_f32_16x16x32_bf16(Bt[n][k], At[m][k], acc[ai][bj][m][n], 0, 0, 0); } } \
        __builtin_amdgcn_s_setprio(0); } while (0)
#define PG8_WAIT_V(n) asm volatile("s_waitcnt vmcnt(" #n ")" ::: "memory")
#define PG8_WAIT_L(n) asm volatile("s_waitcnt lgkmcnt(" #n ")" ::: "memory")
#define PG8_BAR __builtin_amdgcn_s_barrier()
#define PG8_SCHED __builtin_amdgcn_sched_barrier(0)
    Unit cur, nxt; int ui = 0;
    if (!S.next(0, cur)) return;
    f32x4 acc[2][2][4][2];
#pragma unroll
    for (int a = 0; a < 2; ++a)
#pragma unroll
        for (int b = 0; b < 2; ++b)
#pragma unroll
            for (int m = 0; m < 4; ++m)
#pragma unroll
                for (int n = 0; n < 2; ++n) acc[a][b][m][n] = (f32x4){0.f, 0.f, 0.f, 0.f};
    bf16x8 At[4][2], B0[2][2], B1[2][2]; i32x8 At8[4], B08[2], B18[2];
    const char* cA = (const char*)g.A + (size_t)cur.pm * tstepA; const char* cB = (const char*)g.Bt + (size_t)cur.pn * tstep;
    S.a_ready(cur);
    if constexpr (SP2) {
        PG8_STAGE(PG8_SB(0, 0), cB, voffB); PG8_STAGE(PG8_SB(0, 1), cB + hstep, voffB); PG8_STAGE(PG8_SA(0, 0), cA, voffA); PG8_STAGE(PG8_SA(0, 1), cA + hstepA, voffA);
        if (wr == 1) PG8_BAR;
        PG8_WAIT_V(2); PG8_BAR;
        PG8_STAGE(PG8_SB(1, 0), cB + kstep, voffB); PG8_STAGE(PG8_SA(1, 0), cA + kstep, voffA); PG8_STAGE(PG8_SB(1, 1), cB + hstep + kstep, voffB);
        PG8_WAIT_V(6); PG8_BAR;
    } else {
        PG8_STAGE(PG8_SB(0, 0), cB, voffB); PG8_STAGE(PG8_SA(0, 0), cA, voffA); PG8_STAGE(PG8_SB(0, 1), cB + hstep, voffB); PG8_STAGE(PG8_SA(0, 1), cA + hstepA, voffA);
        if (wr == 1) PG8_BAR;
        PG8_WAIT_V(4); PG8_BAR;
        PG8_STAGE(PG8_SB(1, 0), cB + kstep, voffB); PG8_STAGE(PG8_SA(1, 0), cA + kstep, voffA); PG8_STAGE(PG8_SB(1, 1), cB + hstep + kstep, voffB);
        PG8_WAIT_V(6); PG8_BAR;
    }
    for (;;) {
        const bool has_next = S.next(ui + 1, nxt);
        const char* nA = has_next ? (const char*)g.A + (size_t)nxt.pm * tstepA : cA; const char* nB = has_next ? (const char*)g.Bt + (size_t)nxt.pn * tstep : cB;
        for (int t = 0; t < nt; t += 2) {
            const bool last = (t == nt - 2);
            const char* a1 = cA + (size_t)(t + 1) * kstep;
            const char* a2 = last ? nA : cA + (size_t)(t + 2) * kstep; const char* b2 = last ? nB : cB + (size_t)(t + 2) * kstep;
            const char* a3 = a2 + kstep; const char* b3 = b2 + kstep;
            if (last && has_next) S.a_ready(nxt);
            if constexpr (SP2) {
            PG8_LDB(B0, 0, 0); PG8_LDB(B1, 0, 1); PG8_SCHED; PG8_LDA(At, 0, 0); PG8_STAGE(PG8_SA(1, 1), a1 + hstepA, voffA);
            PG8_WAIT_V(8); PG8_WAIT_L(0); PG8_BAR; PG8_MMA(0, 0, At, B0); PG8_MMA(0, 1, At, B1); PG8_BAR; PG8_SCHED;
            PG8_LDA(At, 0, 1); PG8_STAGE(PG8_SB(0, 0), b2, voffB); PG8_STAGE(PG8_SB(0, 1), b2 + hstep, voffB); PG8_STAGE(PG8_SA(0, 0), a2, voffA);
            PG8_WAIT_V(8); PG8_WAIT_L(0); PG8_BAR; PG8_MMA(1, 0, At, B0); PG8_MMA(1, 1, At, B1); PG8_BAR; PG8_SCHED;
            PG8_LDB(B0, 1, 0); PG8_LDB(B1, 1, 1); PG8_SCHED; PG8_LDA(At, 1, 0); PG8_STAGE(PG8_SA(0, 1), a2 + hstepA, voffA);
            PG8_WAIT_V(8); PG8_WAIT_L(0); PG8_BAR; PG8_MMA(0, 0, At, B0); PG8_MMA(0, 1, At, B1); PG8_BAR; PG8_SCHED;
            PG8_LDA(At, 1, 1); PG8_STAGE(PG8_SB(1, 0), b3, voffB); PG8_STAGE(PG8_SB(1, 1), b3 + hstep, voffB); PG8_STAGE(PG8_SA(1, 0), a3, voffA);
            PG8_WAIT_V(8); PG8_WAIT_L(0); PG8_BAR; PG8_MMA(1, 0, At, B0); PG8_MMA(1, 1, At, B1); PG8_BAR; PG8_SCHED;
            } else {
            PG8_LDB(B0, 0, 0); PG8_SCHED; PG8_LDA(At, 0, 0); PG8_STAGE(PG8_SA(1, 1), a1 + hstepA, voffA);
            PG8_WAIT_L(8); PG8_BAR; PG8_WAIT_L(0); PG8_MMA(0, 0, At, B0); PG8_BAR; PG8_SCHED;
            PG8_LDB(B1, 0, 1); PG8_STAGE(PG8_SB(0, 0), b2, voffB);
            PG8_BAR; PG8_WAIT_L(0); PG8_MMA(0, 1, At, B1); PG8_BAR;
            PG8_LDA(At, 0, 1); PG8_STAGE(PG8_SA(0, 0), a2, voffA);
            PG8_BAR; PG8_WAIT_L(0); PG8_MMA(1, 0, At, B0); PG8_BAR; PG8_SCHED;
            PG8_STAGE(PG8_SB(0, 1), b2 + hstep, voffB);
            PG8_WAIT_V(6); PG8_BAR; PG8_MMA(1, 1, At, B1); PG8_BAR;
            PG8_LDB(B0, 1, 0); PG8_SCHED; PG8_LDA(At, 1, 0); PG8_STAGE(PG8_SA(0, 1), a2 + hstepA, voffA);
            PG8_WAIT_L(8); PG8_BAR; PG8_WAIT_L(0); PG8_MMA(0, 0, At, B0); PG8_BAR; PG8_SCHED;
            PG8_LDB(B1, 1, 1); PG8_STAGE(PG8_SB(1, 0), b3, voffB);
            PG8_BAR; PG8_WAIT_L(0); PG8_MMA(0, 1, At, B1); PG8_BAR;
            PG8_LDA(At, 1, 1); PG8_STAGE(PG8_SA(1, 0), a3, voffA);
            PG8_BAR; PG8_WAIT_L(0); PG8_MMA(1, 0, At, B0); PG8_BAR; PG8_SCHED;
            PG8_STAGE(PG8_SB(1, 1), b3 + hstep, voffB);
            PG8_WAIT_V(6); PG8_BAR; PG8_MMA(1, 1, At, B1); PG8_BAR;
            }
        }
        if constexpr (F8) {
            asm volatile("s_nop 15\n\ts_nop 15" ::: "memory");
#pragma unroll
            for (int a_ = 0; a_ < 2; ++a_)
#pragma unroll
                for (int b_ = 0; b_ < 2; ++b_)
#pragma unroll
                    for (int m_ = 0; m_ < 4; ++m_) asm volatile("" : "+v"(acc[a_][b_][m_][0]), "+v"(acc[a_][b_][m_][1]));
        }
        if constexpr (ALIGN_EPI) { if (wr == 0) PG8_BAR; }
        if constexpr (!Epi::AFTER_DRAIN) { E(acc, cur, wr, wc, fr, fq); S.done(cur); }
        if (!has_next) break;
#pragma unroll
        for (int a = 0; a < 2; ++a)
#pragma unroll
            for (int b = 0; b < 2; ++b)
#pragma unroll
                for (int m = 0; m < 4; ++m)
#pragma unroll
                    for (int n = 0; n < 2; ++n) acc[a][b][m][n] = (f32x4){0.f, 0.f, 0.f, 0.f};
        cur = nxt; cA = nA; cB = nB; ++ui;
        if constexpr (ALIGN_EPI) { if (wr == 1) PG8_BAR; }
    }
    PG8_WAIT_V(0);
    if constexpr (!ALIGN_EPI) { if (wr == 0) PG8_BAR; }
    PG8_BAR;
    if constexpr (Epi::AFTER_DRAIN) { E.fused(acc, cur, wr, wc, fr, fq, lds, wid, lane); S.done(cur); }
#undef PG8_SA
#undef PG8_SB
#undef PG8_STAGE
#undef PG8_LDA
#undef PG8_LDB
#undef PG8_MMA
#undef PG8_WAIT_V
#undef PG8_WAIT_L
#undef PG8_BAR
#undef PG8_SCHED
}
}

constexpr int NWAVES = 8, NT = 512;
constexpr int BATCH = 8, SEQ = 2048, DM = 4096, MROWS = BATCH * SEQ, DEPTH = 4, PLE = 256;
constexpr int LDZE = 14848, LDZO = 10496;
constexpr int ZE_QA = 0, ZE_GA = 2048, ZE_QB = 4096, ZE_KB = 6144, ZE_VB = 8192, ZE_GB = 10240, ZE_KA = 12288, ZE_VA = 12416, ZE_IQ = 12544, ZE_IK = 14592, ZE_IW = 14720;
constexpr int ZE_N8 = 12288, ZE_N16 = 2560;
constexpr int ZO_CU = 0, ZO_CV = 2048, ZO_GC = 4096, ZO_GD = 6144, ZO_CQ = 8192, ZO_CKV = 9728, ZO_KR = 10240;
constexpr int EVEN_IN = 14736, ODD_IN = 10304;
constexpr float NORM_EPS = 1e-6f;
constexpr float MIX8_SCALE = 4.0f;
constexpr float A8_SCALE = 8.0f;
constexpr float W8_SCALE = 256.0f;

constexpr size_t MiB = 1u << 20;
constexpr size_t WS_CTL = 0, CTL_ZERO_BYTES = 1 * MiB;
constexpr size_t WS_SCR = 1 * MiB;
constexpr size_t WS_MASK = 33 * MiB;
constexpr size_t WS_STATS = 37 * MiB;
constexpr size_t WS_PB = 38 * MiB;
constexpr size_t WS_CWS = 70 * MiB;
constexpr size_t WS_WINE8 = 71 * MiB;
constexpr size_t WS_WINE16 = 167 * MiB;
constexpr size_t WS_WINO = 207 * MiB;
constexpr size_t WS_WOUT = 289 * MiB;
constexpr size_t WS_WGATE = 353 * MiB;
constexpr size_t WS_WPLE = 417 * MiB;
constexpr size_t WS_WUQ = 425 * MiB;
constexpr size_t WS_WUKV = 443 * MiB;
constexpr size_t WS_H = 451 * MiB;
constexpr size_t WS_H8 = 579 * MiB;
constexpr size_t WS_RAW = 643 * MiB;
constexpr size_t WS_XB = 707 * MiB;
constexpr size_t WS_PS = 835 * MiB;
constexpr size_t WS_RSTD = 840 * MiB;
constexpr size_t WS_X18 = 1413 * MiB;
constexpr size_t WS_Z = 885 * MiB;
constexpr size_t WS_PE = WS_Z;
constexpr size_t WS_CQN = WS_Z + 328 * MiB;
constexpr size_t WS_CKVN = WS_Z + 376 * MiB;
constexpr size_t WS_MIX = 1349 * MiB;
constexpr size_t WS_QF = 1477 * MiB;
constexpr size_t WS_KVF = 1573 * MiB;
constexpr size_t WS_KM = 1701 * MiB;
constexpr size_t WS_END = 1797 * MiB;
constexpr int CW_BAR = 4096;

constexpr int RING_BYTES = 131072;
constexpr int MISC_OFF = RING_BYTES;
constexpr int LDS_BYTES = 147456;

#define GAS __attribute__((address_space(1)))
#define LAS __attribute__((address_space(3)))
typedef unsigned short bf16;
typedef short bf16x8 __attribute__((ext_vector_type(8)));
typedef short s16x4 __attribute__((ext_vector_type(4)));
typedef float f32x4 __attribute__((ext_vector_type(4)));
typedef float f32x2 __attribute__((ext_vector_type(2)));
typedef unsigned u32x4 __attribute__((ext_vector_type(4)));
typedef unsigned u32x2 __attribute__((ext_vector_type(2)));
typedef int i32x4 __attribute__((ext_vector_type(4)));
#define LDS_WAIT() asm volatile("s_waitcnt lgkmcnt(0)" ::: "memory")
#define VM_WAIT() asm volatile("s_waitcnt vmcnt(0)" ::: "memory")
#define MFMA16(a, b, c) __builtin_amdgcn_mfma_f32_16x16x32_bf16((a), (b), (c), 0, 0, 0)
__device__ __forceinline__ unsigned pk2(float lo, float hi) { return pg8::cvt_pk_bf16(lo, hi); }
__device__ __forceinline__ float bflo(unsigned w) { return __uint_as_float(w << 16); }
__device__ __forceinline__ float bfhi(unsigned w) { return __uint_as_float(w & 0xffff0000u); }
__device__ __forceinline__ float fsig(float a) { return pg8::fast_sigmoid(a); }
__device__ __forceinline__ float fsilu(float a) { return a * fsig(a); }
__device__ __forceinline__ float fgelu(float x) { const float y = 0.7978845608028654f * (x + 0.044715f * x * x * x); return x * fsig(2.0f * y); }
__device__ __forceinline__ float shx(float v, int mask, int lane) { return __builtin_bit_cast(float, __builtin_amdgcn_ds_bpermute((lane ^ mask) << 2, __builtin_bit_cast(int, v))); }
__device__ __forceinline__ float xmax16(float v) { unsigned a = __float_as_uint(v), b = a; asm volatile("" : "+v"(b)); const u32x2 r = __builtin_amdgcn_permlane16_swap(a, b, false, false); return __builtin_amdgcn_fmed3f(__uint_as_float(r.x), __uint_as_float(r.y), __builtin_inff()); }
__device__ __forceinline__ float xmax32(float v) { unsigned a = __float_as_uint(v), b = a; asm volatile("" : "+v"(b)); const u32x2 r = __builtin_amdgcn_permlane32_swap(a, b, false, false); return __builtin_amdgcn_fmed3f(__uint_as_float(r.x), __uint_as_float(r.y), __builtin_inff()); }
__device__ __forceinline__ float xsum16(float v) { unsigned a = __float_as_uint(v), b = a; asm volatile("" : "+v"(b)); const u32x2 r = __builtin_amdgcn_permlane16_swap(a, b, false, false); return __uint_as_float(r.x) + __uint_as_float(r.y); }
__device__ __forceinline__ float xsum32(float v) { unsigned a = __float_as_uint(v), b = a; asm volatile("" : "+v"(b)); const u32x2 r = __builtin_amdgcn_permlane32_swap(a, b, false, false); return __uint_as_float(r.x) + __uint_as_float(r.y); }
__device__ __forceinline__ float wave_sum(float v, int lane) {
#pragma unroll
    for (int o = 1; o < 64; o <<= 1) v += shx(v, o, lane);
    return v;
}
__device__ __forceinline__ s16x4 tr_read(const LAS unsigned char* p) { return __builtin_amdgcn_ds_read_tr16_b64_v4i16((LAS s16x4*)p); }
__device__ __forceinline__ bf16x8 cat8(s16x4 a, s16x4 b) { bf16x8 r; r[0] = a[0]; r[1] = a[1]; r[2] = a[2]; r[3] = a[3]; r[4] = b[0]; r[5] = b[1]; r[6] = b[2]; r[7] = b[3]; return r; }

#define XB_TMO      128
#define XB_XCNT(j)  (256  + 64 * (j))
#define XB_XSUB(j)  (1280 + 64 * (j))
#define XB_XGEN(j)  (2304 + 64 * (j))
#define XB_TOP      3328
#define XB_TOPGEN   3392
#define XCD_BAR_WORDS 3456
#define XB_SPIN_CAP (1u << 20)
__device__ __forceinline__ unsigned xb_ld(unsigned* p)              { return __hip_atomic_load(p, __ATOMIC_RELAXED, __HIP_MEMORY_SCOPE_AGENT); }
__device__ __forceinline__ unsigned xb_add(unsigned* p, unsigned v) { return __hip_atomic_fetch_add(p, v, __ATOMIC_RELAXED, __HIP_MEMORY_SCOPE_AGENT); }
__device__ __forceinline__ unsigned xb_xcc_id() { return (unsigned)__builtin_amdgcn_s_getreg((3 << 11) | 20) & 0xFu; }
#define XB_SPIN(cond, bar) do { unsigned _sp = 0; while (cond) { __builtin_amdgcn_s_sleep(1); \
    if ((++_sp & 255u) == 0u) { if (xb_ld(&(bar)[XB_TMO])) break; if (_sp > XB_SPIN_CAP) { atomicAdd(&(bar)[XB_TMO], 1u); break; } } } } while (0)
struct XcdBarrier { unsigned* bar; unsigned x; volatile LAS unsigned* st; int w0; };
__device__ __forceinline__ XcdBarrier xcd_barrier_post(unsigned* bar, volatile LAS unsigned* st) {
    XcdBarrier b; b.bar = bar; b.x = xb_xcc_id(); b.st = st; b.w0 = 0;
    if (threadIdx.x == 0) (void)xb_add(&bar[XB_XCNT(b.x)], 1u);
    return b;
}
__device__ __forceinline__ void xcd_barrier_complete(unsigned* bar, unsigned x, unsigned& nloc, unsigned& nx) {
    const unsigned G = gridDim.x * gridDim.y * gridDim.z;
    unsigned sum, cnt, mine, sp = 0u;
    for (;;) {
        sum = 0u; cnt = 0u; mine = 0u;
#pragma unroll
        for (unsigned j = 0; j < 16; ++j) { const unsigned c = xb_ld(&bar[XB_XCNT(j)]); sum += c; cnt += (c > 0u) ? 1u : 0u; mine = (j == x) ? c : mine; }
        if (sum == G) break;
        __builtin_amdgcn_s_sleep(1);
        if ((++sp & 255u) == 0u) { if (xb_ld(&bar[XB_TMO])) break; if (sp > XB_SPIN_CAP) { atomicAdd(&bar[XB_TMO], 1u); break; } }
    }
    nloc = mine > 0u ? mine : 1u; nx = cnt > 0u ? cnt : 1u;
}
template <bool FIRST>
__device__ __forceinline__ void xcd_barrier_t(const XcdBarrier& b) {
    asm volatile("s_waitcnt vmcnt(0)" ::: "memory");
    __syncthreads();
    if (b.w0 == 0 && pg8::hw_lane() == 0) {
        unsigned* bar = b.bar; asm volatile("" : "+s"(bar));
        __builtin_amdgcn_s_waitcnt(0);
        unsigned nloc = b.st[0], nx = b.st[1];
        if constexpr (FIRST) { if (nloc == 0u) { xcd_barrier_complete(bar, b.x, nloc, nx); b.st[0] = nloc; b.st[1] = nx; } }
        else { nloc = nloc ? nloc : 1u; nx = nx ? nx : 1u; }
        const unsigned old = xb_add(&bar[XB_XSUB(b.x)], 1u);
        const unsigned gen = old / nloc;
        if (old + 1u == (gen + 1u) * nloc) {
            __builtin_amdgcn_fence(__ATOMIC_RELEASE, "agent");
            asm volatile("s_waitcnt vmcnt(0)" ::: "memory");
            const unsigned og = xb_add(&bar[XB_TOP], 1u);
            const unsigned tg = og / nx;
            if (og + 1u == (tg + 1u) * nx) xb_add(&bar[XB_TOPGEN], 1u);
            else XB_SPIN(xb_ld(&bar[XB_TOPGEN]) == tg, bar);
            __builtin_amdgcn_fence(__ATOMIC_ACQUIRE, "agent");
            xb_add(&bar[XB_XGEN(b.x)], 1u);
            asm volatile("s_waitcnt vmcnt(0)" ::: "memory");
        } else {
            XB_SPIN(xb_ld(&bar[XB_XGEN(b.x)]) == gen, bar);
            __builtin_amdgcn_fence(__ATOMIC_ACQUIRE, "agent");
            asm volatile("s_waitcnt vmcnt(0)" ::: "memory");
        }
    }
    __syncthreads();
}

struct Args { const void* in[22]; float* out; unsigned char* ws; int lo, hi; };
#define OPAQUE_TID() do { int t_ = (F.w0 << 6) | pg8::hw_lane(); asm volatile("" : "+v"(t_)); F.tid = t_; F.lane = t_ & 63; F.wave = __builtin_amdgcn_readfirstlane(t_ >> 6); int g_ = gridDim.x, c_ = blockIdx.x; asm volatile("" : "+s"(g_), "+s"(c_)); F.G = g_; F.c = c_; F.vc = (g_ % 8 == 0) ? (c_ % 8) * (g_ / 8) + c_ / 8 : c_; } while (0)
struct Frame {
    LAS unsigned char* lds;
    int tid, lane, wave, w0, G, c, vc;
    unsigned char* ws;
};

struct Task { int in_idx, src_off, K, Nsrc, c0, nvalid, ntot, dst_row0; unsigned dst_kb; int item0; int f8; float wsc; int gain_off; };
constexpr int NTASK = 42;
struct TaskTable { Task t[NTASK]; int total; };
constexpr TaskTable make_tasks() {
    TaskTable T{}; int n = 0;
    for (int j = 0; j < 2; ++j) {
        const int so = j * 4096 * EVEN_IN; const unsigned d8 = (unsigned)((WS_WINE8 + (size_t)j * 48 * MiB) >> 10), d16 = (unsigned)((WS_WINE16 + (size_t)j * 20 * MiB) >> 10);
        const int seg8[6][4] = {{0, 2048, 2048, ZE_QA}, {4496, 2048, 2048, ZE_GA}, {6544, 2048, 2048, ZE_QB}, {8592, 2048, 2048, ZE_KB}, {10640, 2048, 2048, ZE_VB}, {12688, 2048, 2048, ZE_GB}};
        const int seg16[3][4] = {{2048, 256, 256, ZE_KA - ZE_N8}, {2304, 2048, 2048, ZE_IQ - ZE_N8}, {4352, 144, 256, ZE_IK - ZE_N8}};
        for (int s = 0; s < 6; ++s) T.t[n++] = Task{4, so, 4096, EVEN_IN, seg8[s][0], seg8[s][1], seg8[s][2], seg8[s][3], d8, 0, 1, W8_SCALE, (2 * j) * 4096};
        for (int s = 0; s < 3; ++s) T.t[n++] = Task{4, so, 4096, EVEN_IN, seg16[s][0], seg16[s][1], seg16[s][2], seg16[s][3], d16, 0, 0, 1.0f, (2 * j) * 4096};
    }
    for (int j = 0; j < 2; ++j) {
        const int so = j * 4096 * ODD_IN; const unsigned d = (unsigned)((WS_WINO + (size_t)j * 41 * MiB) >> 10);
        const int seg[4][4] = {{0, 6144, 6144, ZO_CU}, {8256, 2048, 2048, ZO_GD}, {6144, 2048, 2048, ZO_CQ}, {8192, 64, 256, ZO_KR}};
        for (int s = 0; s < 4; ++s) T.t[n++] = Task{9, so, 4096, ODD_IN, seg[s][0], seg[s][1], seg[s][2], seg[s][3], d, 0, 1, W8_SCALE, (2 * j + 1) * 4096};
    }
    for (int i = 0; i < 4; ++i) T.t[n++] = Task{(i & 1) ? 19 : 8, (i >> 1) * 4096 * 4096, 4096, 4096, 0, 4096, 4096, 0, (unsigned)((WS_WOUT + (size_t)i * 16 * MiB) >> 10), 0, 1, W8_SCALE, -1};
    for (int i = 0; i < 4; ++i) T.t[n++] = Task{21, i * 4096 * 4096, 4096, 4096, 0, 4096, 4096, 0, (unsigned)((WS_WGATE + (size_t)i * 16 * MiB) >> 10), 0, 1, W8_SCALE, -1};
    for (int i = 0; i < 4; ++i) T.t[n++] = Task{20, i * 256 * 4096, 256, 4096, 0, 4096, 4096, 0, (unsigned)((WS_WPLE + (size_t)i * 2 * MiB) >> 10), 0, 1, W8_SCALE, -1};
    for (int j = 0; j < 2; ++j) T.t[n++] = Task{15, j * 1536 * 3072, 1536, 3072, 0, 3072, 3072, 0, (unsigned)((WS_WUQ + (size_t)j * 9 * MiB) >> 10), 0, 1, W8_SCALE, -1};
    for (int j = 0; j < 2; ++j) T.t[n++] = Task{16, j * 512 * 4096, 512, 4096, 0, 4096, 4096, 0, (unsigned)((WS_WUKV + (size_t)j * 4 * MiB) >> 10), 0, 1, W8_SCALE, -1};
    int acc = 0;
    for (int i = 0; i < NTASK; ++i) { T.t[i].item0 = acc; acc += (T.t[i].K / 64) * (T.t[i].ntot / 64); }
    T.total = acc;
    return T;
}
__constant__ TaskTable g_tasks = make_tasks();

struct ItemDesc { const float* src; bf16* dst; const float* gain; int K, Nsrc, f8; float wsc; bool ok; };
__device__ __forceinline__ ItemDesc item_desc(const Args& A, unsigned char* ws, int it_, int lane, int& ti_) {
    const int it = __builtin_amdgcn_readfirstlane(it_); int ti = __builtin_amdgcn_readfirstlane(ti_);
#pragma unroll 1
    while (ti + 1 < NTASK && it >= g_tasks.t[ti + 1].item0) ++ti;
    ti_ = ti;
    const Task tk = g_tasks.t[ti]; const int item = it - tk.item0;
    const int nblk = tk.ntot / 64, kb = item / nblk, nb = item - kb * nblk, k0 = 64 * kb, n0 = 64 * nb, rgrp = lane >> 4, c4 = lane & 15;
    ItemDesc d; d.K = tk.K; d.Nsrc = tk.Nsrc; d.f8 = tk.f8; d.wsc = tk.wsc; d.ok = (n0 + 4 * c4) < tk.nvalid;
    d.src = (const float*)A.in[tk.in_idx] + tk.src_off + (size_t)(k0 + rgrp) * tk.Nsrc + tk.c0 + n0 + 4 * c4;
    d.gain = tk.gain_off >= 0 ? (const float*)A.in[3] + tk.gain_off + k0 : (const float*)nullptr;
    d.dst = (bf16*)(ws + ((size_t)tk.dst_kb << 10));
    d.dst = (bf16*)((unsigned char*)d.dst + ((size_t)(tk.dst_row0 + n0) * tk.K + k0) * (tk.f8 ? 1 : 2));
    return d;
}
__device__ __forceinline__ void item_load(const ItemDesc& d, f32x4 (&v)[16]) {
#pragma unroll
    for (int i = 0; i < 16; ++i) v[i] = d.ok ? *(const f32x4*)(d.src + (size_t)(4 * i) * d.Nsrc) : (f32x4){0.f, 0.f, 0.f, 0.f};
}
__device__ __forceinline__ void item_store(const ItemDesc& d, const f32x4 (&v)[16], LAS float* scr, int lane) {
    const int rgrp = lane >> 4, c4 = lane & 15;
#pragma unroll
    for (int i = 0; i < 16; ++i) { const int row = 4 * i + rgrp; *(LAS f32x4*)(scr + row * 64 + ((c4 ^ ((row >> 3) & 7)) << 2)) = v[i]; }
    LDS_WAIT(); asm volatile("" ::: "memory");
    const int c = lane & 7, nl = lane >> 3; const float wsc = d.wsc;
    float gk[8];
    { f32x4 ga = {1.f, 1.f, 1.f, 1.f}, gb = ga; if (d.gain) { ga = *(const f32x4*)(d.gain + 8 * c); gb = *(const f32x4*)(d.gain + 8 * c + 4); }
#pragma unroll
      for (int e = 0; e < 4; ++e) { gk[e] = ga[e] * wsc; gk[4 + e] = gb[e] * wsc; } }
#pragma unroll
    for (int j = 0; j < 8; ++j) { const int n = nl + 8 * j; const LAS float* s = scr + (8 * c) * 64 + ((((n >> 2) ^ c) << 2) + (n & 3));
        if (d.f8) { u32x2 o; o.x = pg8::cvt_pk4_fp8(s[0 * 64] * gk[0], s[1 * 64] * gk[1], s[2 * 64] * gk[2], s[3 * 64] * gk[3]); o.y = pg8::cvt_pk4_fp8(s[4 * 64] * gk[4], s[5 * 64] * gk[5], s[6 * 64] * gk[6], s[7 * 64] * gk[7]);
            *(u32x2*)((unsigned char*)d.dst + (size_t)n * d.K + 8 * c) = o; }
        else { u32x4 o; o.x = pk2(s[0 * 64] * gk[0], s[1 * 64] * gk[1]); o.y = pk2(s[2 * 64] * gk[2], s[3 * 64] * gk[3]); o.z = pk2(s[4 * 64] * gk[4], s[5 * 64] * gk[5]); o.w = pk2(s[6 * 64] * gk[6], s[7 * 64] * gk[7]);
            *(u32x4*)(d.dst + (size_t)n * d.K + 8 * c) = o; } }
    LDS_WAIT(); asm volatile("" ::: "memory");
}
__device__ __forceinline__ void prologue_phase(Frame& F, const Args& A) {
    OPAQUE_TID();
    LAS float* scr = (LAS float*)(F.lds + F.wave * 16384);
    const int gw = F.c * NWAVES + F.wave, NGW = F.G * NWAVES;
    const int total = g_tasks.total;
    if (gw < total) {
        int ti = 0; ItemDesc cur = item_desc(A, F.ws, gw, F.lane, ti); f32x4 vc[16], vn[16]; item_load(cur, vc);
        for (int it = gw; it < total; it += NGW) {
            const bool more = (it + NGW < total);
            ItemDesc nxt = cur; if (more) { nxt = item_desc(A, F.ws, it + NGW, F.lane, ti); item_load(nxt, vn); }
            item_store(cur, vc, scr, F.lane);
            cur = nxt;
#pragma unroll
            for (int i = 0; i < 16; ++i) vc[i] = vn[i];
        }
    }
    { const f32x4* p4 = (const f32x4*)A.in[1]; unsigned* o = (unsigned*)(F.ws + WS_PB); const size_t n4 = (size_t)DEPTH * MROWS * PLE / 4;
      const size_t st = (size_t)F.G * NT;
      for (size_t i = (size_t)F.c * NT + F.tid; i < n4; i += 4 * st) { f32x4 v[4];
#pragma unroll
          for (int k = 0; k < 4; ++k) { const size_t j = i + k * st; v[k] = p4[j < n4 ? j : n4 - 1]; }
          asm volatile("" : "+v"(v[0]), "+v"(v[1]), "+v"(v[2]), "+v"(v[3]));
#pragma unroll
          for (int k = 0; k < 4; ++k) { const size_t j = i + k * st; if (j < n4) o[j] = pg8::cvt_pk4_fp8(v[k][0] * A8_SCALE, v[k][1] * A8_SCALE, v[k][2] * A8_SCALE, v[k][3] * A8_SCALE); } } }
    { const float* w = (const float*)A.in[11]; bf16* o = (bf16*)(F.ws + WS_CWS); const int n = 2 * 16 * 128 * 128;
      for (int i = F.c * NT + F.tid; i < n / 2; i += F.G * NT) { const int e = 2 * i, t = (e >> 7) & 127, s = e & 127; const float a = (s <= t) ? w[e] : 0.f, b = (s + 1 <= t) ? w[e + 1] : 0.f; ((unsigned*)o)[i] = pk2(a, b); } }
}

__device__ __forceinline__ void rmsnorm_phase(Frame& F, const float* xf, const float* PS, float* RSTD, bf16* H, unsigned char* H8) {
    OPAQUE_TID();
    const int gw = F.c * NWAVES + F.wave, NGW = F.G * NWAVES;
    if (xf) {
        for (int m = gw; m < MROWS; m += NGW) {
            const f32x4* xr = (const f32x4*)(xf + (size_t)m * DM) + F.lane; f32x4 v[16]; float ss = 0.f;
#pragma unroll
            for (int j = 0; j < 16; ++j) { v[j] = xr[64 * j]; ss += (v[j][0] * v[j][0] + v[j][1] * v[j][1]) + (v[j][2] * v[j][2] + v[j][3] * v[j][3]); }
            const float rstd = rsqrtf(wave_sum(ss, F.lane) * (1.0f / DM) + NORM_EPS);
            if (F.lane == 0) RSTD[m] = rstd;
            u32x2* o = (u32x2*)(H + (size_t)m * DM) + F.lane; unsigned* o8 = (unsigned*)(H8 + (size_t)m * DM) + F.lane;
#pragma unroll
            for (int j = 0; j < 16; ++j) { o8[64 * j] = pg8::cvt_pk4_fp8(v[j][0], v[j][1], v[j][2], v[j][3]); u32x2 w; w.x = pk2(v[j][0], v[j][1]); w.y = pk2(v[j][2], v[j][3]); o[64 * j] = w; }
        }
    } else {
        for (int m = F.c * NT + F.tid; m < MROWS; m += F.G * NT) {
            const f32x4* p = (const f32x4*)(PS + (size_t)m * 64); f32x4 pv[16];
#pragma unroll
            for (int j = 0; j < 16; ++j) pv[j] = p[j];
            asm volatile("" : "+v"(pv[0]), "+v"(pv[1]), "+v"(pv[2]), "+v"(pv[3]), "+v"(pv[4]), "+v"(pv[5]), "+v"(pv[6]), "+v"(pv[7]), "+v"(pv[8]), "+v"(pv[9]), "+v"(pv[10]), "+v"(pv[11]), "+v"(pv[12]), "+v"(pv[13]), "+v"(pv[14]), "+v"(pv[15]));
            f32x4 a = pv[0];
#pragma unroll
            for (int j = 1; j < 16; ++j) a = a + pv[j];
            RSTD[m] = rsqrtf(((a[0] + a[1]) + (a[2] + a[3])) * (1.0f / DM) + NORM_EPS);
        }
    }
}
__device__ __forceinline__ void prep_even_phase(Frame& F, bf16* Z, const float* akn) {
    OPAQUE_TID();
    const int gw = F.c * NWAVES + F.wave, NGW = F.G * NWAVES, l = F.lane, li = l & 15;
    const f32x4 ga = *(const f32x4*)(akn + 8 * li), gb = *(const f32x4*)(akn + 8 * li + 4);
    for (int m4 = gw; m4 < MROWS / 4; m4 += NGW) {
        u32x4* p = (u32x4*)(Z + (size_t)(4 * m4 + (l >> 4)) * LDZE + ZE_KA + 8 * li); const u32x4 w = *p; float v[8];
#pragma unroll
        for (int e = 0; e < 4; ++e) { v[2 * e] = bflo(w[e]); v[2 * e + 1] = bfhi(w[e]); }
        float ss = 0.f;
#pragma unroll
        for (int e = 0; e < 8; ++e) ss += v[e] * v[e];
        ss += shx(ss, 1, l); ss += shx(ss, 2, l); ss += shx(ss, 4, l); ss += shx(ss, 8, l);
        const float rstd = rsqrtf(ss * (1.0f / 128.0f) + NORM_EPS);
        u32x4 o; o.x = pk2(v[0] * rstd * ga[0], v[1] * rstd * ga[1]); o.y = pk2(v[2] * rstd * ga[2], v[3] * rstd * ga[3]); o.z = pk2(v[4] * rstd * gb[0], v[5] * rstd * gb[1]); o.w = pk2(v[6] * rstd * gb[2], v[7] * rstd * gb[3]);
        *p = o;
    }
}
__device__ __forceinline__ void prep_odd1_phase(Frame& F, const bf16* Z, const float* qlg, const float* kvlg, unsigned char* CQN, unsigned char* CKVN, float* STATS) {
    OPAQUE_TID();
    const int gw = F.c * NWAVES + F.wave, NGW = F.G * NWAVES, l = F.lane;
    u32x4 cur[8], nxt[8];
#define PO_LOAD(dst, m_) do { const bf16* zr_ = Z + (size_t)(m_) * LDZO; _Pragma("unroll") for (int j = 0; j < 3; ++j) dst[j] = ((const u32x4*)(zr_ + ZO_CQ + 24 * l))[j]; dst[3] = *(const u32x4*)(zr_ + ZO_CKV + 8 * l); \
        _Pragma("unroll") for (int j = 0; j < 4; ++j) dst[4 + j] = ((const u32x4*)(zr_ + ZO_CV + 32 * l))[j]; } while (0)
    f32x4 gq[6], gkv[2];
#pragma unroll
    for (int j = 0; j < 6; ++j) gq[j] = ((const f32x4*)(qlg + 24 * l))[j];
    gkv[0] = *(const f32x4*)(kvlg + 8 * l); gkv[1] = *(const f32x4*)(kvlg + 8 * l + 4);
    if (gw < MROWS) PO_LOAD(cur, gw);
    for (int m = gw; m < MROWS; m += NGW) {
        const bool more = (m + NGW < MROWS);
        if (more) PO_LOAD(nxt, m + NGW);
        { float v[24]; float ss = 0.f;
#pragma unroll
          for (int j = 0; j < 3; ++j)
#pragma unroll
              for (int e = 0; e < 4; ++e) { v[8 * j + 2 * e] = bflo(cur[j][e]); v[8 * j + 2 * e + 1] = bfhi(cur[j][e]); }
#pragma unroll
          for (int e = 0; e < 24; ++e) ss += v[e] * v[e];
          const float rstd = rsqrtf(wave_sum(ss, l) * (1.0f / 1536.0f) + NORM_EPS) * A8_SCALE; u32x2* o = (u32x2*)(CQN + (size_t)m * 1536 + 24 * l);
#pragma unroll
          for (int j = 0; j < 3; ++j) { const f32x4 ga = gq[2 * j], gb = gq[2 * j + 1]; u32x2 w;
              w.x = pg8::cvt_pk4_fp8(v[8 * j + 0] * rstd * ga[0], v[8 * j + 1] * rstd * ga[1], v[8 * j + 2] * rstd * ga[2], v[8 * j + 3] * rstd * ga[3]);
              w.y = pg8::cvt_pk4_fp8(v[8 * j + 4] * rstd * gb[0], v[8 * j + 5] * rstd * gb[1], v[8 * j + 6] * rstd * gb[2], v[8 * j + 7] * rstd * gb[3]); o[j] = w; } }
        { float v[8]; float ss = 0.f;
#pragma unroll
          for (int e = 0; e < 4; ++e) { v[2 * e] = bflo(cur[3][e]); v[2 * e + 1] = bfhi(cur[3][e]); }
#pragma unroll
          for (int e = 0; e < 8; ++e) ss += v[e] * v[e];
          const float rstd = rsqrtf(wave_sum(ss, l) * (1.0f / 512.0f) + NORM_EPS) * A8_SCALE; const f32x4 ga = gkv[0], gb = gkv[1];
          u32x2 o; o.x = pg8::cvt_pk4_fp8(v[0] * rstd * ga[0], v[1] * rstd * ga[1], v[2] * rstd * ga[2], v[3] * rstd * ga[3]); o.y = pg8::cvt_pk4_fp8(v[4] * rstd * gb[0], v[5] * rstd * gb[1], v[6] * rstd * gb[2], v[7] * rstd * gb[3]);
          *(u32x2*)(CKVN + (size_t)m * 512 + 8 * l) = o; }
        { float v[32]; float s1 = 0.f;
#pragma unroll
          for (int j = 0; j < 4; ++j)
#pragma unroll
              for (int e = 0; e < 4; ++e) { v[8 * j + 2 * e] = fgelu(bflo(cur[4 + j][e])); v[8 * j + 2 * e + 1] = fgelu(bfhi(cur[4 + j][e])); }
#pragma unroll
          for (int e = 0; e < 32; ++e) s1 += v[e];
          const float mean = wave_sum(s1, l) * (1.0f / 2048.0f); float s2 = 0.f;
#pragma unroll
          for (int e = 0; e < 32; ++e) { const float d = v[e] - mean; s2 += d * d; }
          const float rstd = rsqrtf(wave_sum(s2, l) * (1.0f / 2048.0f) + NORM_EPS);
          if (l == 0) { f32x2 st; st.x = mean; st.y = rstd; *(f32x2*)(STATS + 2 * (size_t)m) = st; } }
#pragma unroll
        for (int j = 0; j < 8; ++j) cur[j] = nxt[j];
    }
#undef PO_LOAD
}
__device__ __forceinline__ void prep_odd2_phase(Frame& F, bf16* QF, const bf16* KVF, const bf16* Z, bf16* KM, const int* pos, const float* qn, const float* kn) {
    OPAQUE_TID();
    (void)QF; (void)qn;
    const int gw = F.c * NWAVES + F.wave, NGW = F.G * NWAVES, l = F.lane, hd = l >> 2, pl = l & 3;
    float invf[8];
#pragma unroll
    for (int e = 0; e < 8; ++e) invf[e] = exp2f(-(float)(8 * pl + e) * (13.287712379549449f / 32.0f));
    f32x4 gk[8], r1a, r1b, r2a, r2b;
#pragma unroll
    for (int j = 0; j < 8; ++j) gk[j] = ((const f32x4*)(kn + 32 * pl))[j];
    r1a = *(const f32x4*)(kn + 128 + 8 * pl); r1b = *(const f32x4*)(kn + 132 + 8 * pl); r2a = *(const f32x4*)(kn + 160 + 8 * pl); r2b = *(const f32x4*)(kn + 164 + 8 * pl);
    u32x4 cur[6], nxt[6]; int pcur = 0, pnxt = 0;
#define P2_LOAD(dst, pd, m_) do { const bf16* k_ = KVF + (size_t)(m_) * 4096 + hd * 256; const bf16* r_ = Z + (size_t)(m_) * LDZO + ZO_KR; \
        _Pragma("unroll") for (int j = 0; j < 4; ++j) dst[j] = ((const u32x4*)(k_ + 32 * pl))[j]; \
        dst[4] = *(const u32x4*)(r_ + 8 * pl); dst[5] = *(const u32x4*)(r_ + 32 + 8 * pl); pd = pos[m_]; } while (0)
    if (gw < MROWS) P2_LOAD(cur, pcur, gw);
    for (int m = gw; m < MROWS; m += NGW) {
        const bool more = (m + NGW < MROWS);
        if (more) P2_LOAD(nxt, pnxt, m + NGW);
        const float fp = (float)pcur;
        float cs[8], sn[8];
#pragma unroll
        for (int e = 0; e < 8; ++e) { const float ang = fp * invf[e]; float tr = ang * 0.15915494309189535f; tr = tr - floorf(tr); sn[e] = __builtin_amdgcn_sinf(tr); cs[e] = __builtin_amdgcn_cosf(tr); }
        {
            bf16* dst = KM + ((size_t)((m >> 11) * 16 + hd) * SEQ + (m & (SEQ - 1))) * 192;
            float v[32], a1[8], a2[8]; float ss = 0.f;
#pragma unroll
            for (int j = 0; j < 4; ++j)
#pragma unroll
                for (int e = 0; e < 4; ++e) { const unsigned w = cur[j][e]; v[8 * j + 2 * e] = bflo(w); v[8 * j + 2 * e + 1] = bfhi(w); }
#pragma unroll
            for (int e = 0; e < 4; ++e) { const unsigned w1 = cur[4][e], w2 = cur[5][e]; a1[2 * e] = bflo(w1); a1[2 * e + 1] = bfhi(w1); a2[2 * e] = bflo(w2); a2[2 * e + 1] = bfhi(w2); }
#pragma unroll
            for (int e = 0; e < 32; ++e) ss += v[e] * v[e];
#pragma unroll
            for (int e = 0; e < 8; ++e) ss += a1[e] * a1[e] + a2[e] * a2[e];
            ss += shx(ss, 1, l); ss += shx(ss, 2, l);
            const float rstd = rsqrtf(ss * (1.0f / 192.0f) + NORM_EPS);
#pragma unroll
            for (int j = 0; j < 4; ++j) { const f32x4 ga = gk[2 * j], gb = gk[2 * j + 1]; u32x4 o;
                o.x = pk2(v[8 * j + 0] * rstd * ga[0], v[8 * j + 1] * rstd * ga[1]); o.y = pk2(v[8 * j + 2] * rstd * ga[2], v[8 * j + 3] * rstd * ga[3]);
                o.z = pk2(v[8 * j + 4] * rstd * gb[0], v[8 * j + 5] * rstd * gb[1]); o.w = pk2(v[8 * j + 6] * rstd * gb[2], v[8 * j + 7] * rstd * gb[3]); ((u32x4*)(dst + 32 * pl))[j] = o; }
            float o1[8], o2[8];
#pragma unroll
            for (int e = 0; e < 8; ++e) { const float g1 = e < 4 ? r1a[e & 3] : r1b[e & 3], g2 = e < 4 ? r2a[e & 3] : r2b[e & 3]; const float y1 = a1[e] * rstd * g1, y2 = a2[e] * rstd * g2; o1[e] = y1 * cs[e] - y2 * sn[e]; o2[e] = y1 * sn[e] + y2 * cs[e]; }
            u32x4 w1, w2; w1.x = pk2(o1[0], o1[1]); w1.y = pk2(o1[2], o1[3]); w1.z = pk2(o1[4], o1[5]); w1.w = pk2(o1[6], o1[7]); w2.x = pk2(o2[0], o2[1]); w2.y = pk2(o2[2], o2[3]); w2.z = pk2(o2[4], o2[5]); w2.w = pk2(o2[6], o2[7]);
            *(u32x4*)(dst + 128 + 8 * pl) = w1; *(u32x4*)(dst + 160 + 8 * pl) = w2;
        }
#pragma unroll
        for (int j = 0; j < 6; ++j) cur[j] = nxt[j];
        pcur = pnxt;
    }
#undef P2_LOAD
}
__device__ __forceinline__ void indexer_phase(Frame& F, const bf16* Z, unsigned* MASK, float* SCR) {
    OPAQUE_TID();
    const int tid = F.tid, l = F.lane, w = F.wave, li = l & 15, g = l >> 4;
    LAS unsigned char* iql = F.lds;
    LAS float* wl = (LAS float*)(F.lds + 65536);
    float* scr = SCR + (size_t)F.c * (16 * 2048);
    for (int r = 0;; ++r) {
        const int u = r * F.G + F.c; if (u >= BATCH * 128) break;
        const int b = u >> 7; int qg = u & 127; if (r & 1) qg = 127 - qg;
        const int t0 = qg * 16; const size_t row0 = (size_t)b * SEQ;
        { u32x4 iv[8];
#pragma unroll
          for (int r8 = 0; r8 < 8; ++r8) { const int ci = tid + 512 * r8, q = ci >> 8, hc = ci & 255, h = hc >> 4, c8 = hc & 15;
              iv[r8] = *(const u32x4*)(Z + (row0 + t0 + q) * LDZE + ZE_IQ + h * 128 + c8 * 8); }
          asm volatile("" : "+v"(iv[0]), "+v"(iv[1]), "+v"(iv[2]), "+v"(iv[3]), "+v"(iv[4]), "+v"(iv[5]), "+v"(iv[6]), "+v"(iv[7]));
#pragma unroll
          for (int r8 = 0; r8 < 8; ++r8) { const int ci = tid + 512 * r8, q = ci >> 8, hc = ci & 255, h = hc >> 4, c8 = hc & 15;
              *(LAS u32x4*)(iql + (h * 4 + (c8 >> 2)) * 1024 + ((c8 & 3) * 16 + q) * 16) = iv[r8]; } }
        if (tid < 256) { const int q = tid >> 4, h = tid & 15; wl[h * 16 + q] = __uint_as_float((unsigned)Z[(row0 + t0 + q) * LDZE + ZE_IW + h] << 16) * 0.022097086912079608f; }
        __syncthreads();
        const int ngrp = (qg + 4) >> 2;
        bf16x8 a[4][4], an[2][4];
#define IX_LOAD(dst, grp_, t0_, nt_) do { _Pragma("unroll") for (int tl = 0; tl < (nt_); ++tl) _Pragma("unroll") for (int kk = 0; kk < 4; ++kk) \
            dst[tl][kk] = *(const bf16x8*)(Z + (row0 + (grp_) * 64 + ((t0_) + tl) * 16 + li) * LDZE + ZE_IK + kk * 32 + 8 * g); } while (0)
        if (w < ngrp) IX_LOAD(a, w, 0, 4);
        for (int grp = w; grp < ngrp; grp += 8) {
            const bool nx = (grp + 8 < ngrp);
            if (nx) IX_LOAD(an, grp + 8, 0, 2);
            f32x4 sc[4];
#pragma unroll
            for (int tl = 0; tl < 4; ++tl) sc[tl] = (f32x4){0.f, 0.f, 0.f, 0.f};
#pragma unroll 2
            for (int h = 0; h < 16; ++h) {
                const float wq = wl[h * 16 + li];
                bf16x8 bq[4];
#pragma unroll
                for (int kk = 0; kk < 4; ++kk) bq[kk] = *(const LAS bf16x8*)(iql + (h * 4 + kk) * 1024 + l * 16);
#pragma unroll
                for (int tl = 0; tl < 4; ++tl) { f32x4 acc = (f32x4){0.f, 0.f, 0.f, 0.f};
#pragma unroll
                    for (int kk = 0; kk < 4; ++kk) acc = MFMA16(a[tl][kk], bq[kk], acc);
#pragma unroll
                    for (int e = 0; e < 4; ++e) sc[tl][e] += wq * fmaxf(acc[e], 0.f); }
            }
#pragma unroll
            for (int tl = 0; tl < 4; ++tl) *(f32x4*)(scr + li * 2048 + grp * 64 + tl * 16 + 4 * g) = sc[tl];
            if (nx) {
#pragma unroll
                for (int tl = 0; tl < 2; ++tl)
#pragma unroll
                    for (int kk = 0; kk < 4; ++kk) a[tl][kk] = an[tl][kk];
#pragma unroll
                for (int tl = 0; tl < 2; ++tl)
#pragma unroll
                    for (int kk = 0; kk < 4; ++kk) a[2 + tl][kk] = *(const bf16x8*)(Z + (row0 + (grp + 8) * 64 + (2 + tl) * 16 + li) * LDZE + ZE_IK + kk * 32 + 8 * g);
            }
        }
#undef IX_LOAD
        VM_WAIT(); __syncthreads();
#pragma unroll 1
        for (int qq = 0; qq < 2; ++qq) {
            const int qi = 2 * w + qq, t = t0 + qi, n = t + 1, nch = (n + 63) >> 6;
            unsigned uk[32];
#pragma unroll
            for (int c = 0; c < 32; ++c) { unsigned x = 0u;
                { const int key = c * 64 + l; const unsigned bits = __float_as_uint(scr[qi * 2048 + key]); const unsigned ord = bits ^ ((bits >> 31) ? 0xffffffffu : 0x80000000u); x = (key <= t) ? ord : 0u; }
                uk[c] = x; }
            unsigned T = 1u;
            if (n > 256) { T = 0u;
#pragma unroll 1
                for (int bit = 31; bit >= 0; --bit) { const unsigned cand = T | (1u << bit); int cnt = 0;
#pragma unroll
                    for (int c = 0; c < 32; ++c) cnt += __popcll(__ballot(uk[c] >= cand));
                    if (cnt >= 256) { T = cand; if (cnt == 256) break; } } }
            unsigned lo = 0u, hi = 0u;
#pragma unroll
            for (int c = 0; c < 32; ++c) { const unsigned long long bal = __ballot(uk[c] >= T); if (l == c) { lo = (unsigned)bal; hi = (unsigned)(bal >> 32); } }
            if (l < 32) { u32x2 mw; mw.x = lo; mw.y = hi; *(u32x2*)(MASK + (row0 + t) * 64 + 2 * l) = mw; }
        }
        __syncthreads();
    }
}

__device__ __forceinline__ void glds16(const void* gsrc, unsigned lds_dst) { unsigned keep;
    asm volatile("s_mov_b32 %0, m0\n\ts_mov_b32 m0, %2\n\ts_nop 0\n\tglobal_load_lds_dwordx4 %1, off\n\ts_mov_b32 m0, %0" : "=&s"(keep) : "v"(gsrc), "s"(lds_dst) : "memory"); }
#define ATT_WAIT_BAR(N) asm volatile("s_waitcnt vmcnt(" #N ") lgkmcnt(0)\n\ts_barrier" ::: "memory")
template <int MODE> struct AC;
template <> struct AC<0> { static constexpr int DQK = 128, DV = 128, NSUB = 2, NU = 1024; };
template <> struct AC<1> { static constexpr int DQK = 192, DV = 128, NSUB = 2, NU = 1024; };
template <> struct AC<2> { static constexpr int DQK = 256, DV = 256, NSUB = 1, NU = 1024; };
struct AttnP { const bf16* q; int qs; const bf16* k; int ks; const bf16* v; int vs; const bf16* gate; int gs; unsigned char* mix; const int* pos; const unsigned* mask; const float* gn; const float* gk; };

template <int MODE>
__device__ __forceinline__ void attn_phase(Frame& F, const AttnP P) {
    constexpr int DQK = AC<MODE>::DQK, DV = AC<MODE>::DV, NSUB = AC<MODE>::NSUB, NU = AC<MODE>::NU;
    constexpr int KK = DQK / 32, NDT = DV / 16, KCH = DQK / 8, VCH = DV / 8, NKC = 64 * KCH / NT, NVC = 64 * VCH / NT, KT = 64 * DQK * 2, VT = 64 * DV * 2, BUFB = KT + VT;
    constexpr float QC1 = (MODE == 0) ? 0.08838834764831845f * 1.4426950408889634f : (MODE == 1 ? 0.07216878364870322f * 1.4426950408889634f : 1.0f);
    constexpr int QPW = (MODE == 1) ? 32 : 16;
    constexpr int NBUF = 3, NKF = 4 * KK, NPIECE = NKF + 2 * NDT, NPW = NPIECE / NWAVES;
    static_assert(NPIECE % NWAVES == 0 && NKF % NWAVES == 0 && (NPW == 4 || NPW == 5), "piece deal");
    static_assert(NBUF * BUFB + (MODE == 0 ? 4096 + 8192 : 0) <= RING_BYTES, "attention LDS");
    OPAQUE_TID();
    const int tid = F.tid, l = F.lane, w = F.wave, li = l & 15, g = l >> 4;
    LAS unsigned char* lds = F.lds;
    LAS unsigned* mlds = (LAS unsigned*)(lds + NBUF * BUFB);
    LAS int* plds = (LAS int*)(lds + NBUF * BUFB + 4096);
    const unsigned lds0 = (unsigned)(__UINTPTR_TYPE__)lds;
    const float NEG_INF = -__builtin_inff();
    bf16x8 ones8; { const u32x4 o1 = {0x3f803f80u, 0x3f803f80u, 0x3f803f80u, 0x3f803f80u}; ones8 = __builtin_bit_cast(bf16x8, o1); }
    for (int r = 0;; ++r) {
        const int u = r * F.G + F.vc; if (u >= NU) break;
        int b, h = 0, tq0, qbase, nkt;
        if (MODE == 0) { b = u >> 7; int qg = u & 127; if (r & 1) qg = 127 - qg; tq0 = qg * 16; qbase = tq0; nkt = (qg >> 2) + 1; }
        else if (MODE == 1) { const int bh = u >> 3; int qb = u & 7; if (r & 1) qb = 7 - qb; tq0 = qb * 256; qbase = tq0 + 32 * w; nkt = 4 * (qb + 1); b = bh >> 4; h = bh & 15; }
        else { const int bh = u >> 4; int qb = u & 15; if (r & 1) qb = 15 - qb; tq0 = qb * 128; qbase = tq0 + 16 * w; nkt = 2 * (qb + 1); b = bh >> 3; h = bh & 7; }
        const size_t row0 = (size_t)b * SEQ;
        int tqs[NSUB];
#pragma unroll
        for (int s = 0; s < NSUB; ++s) tqs[s] = qbase + li + ((MODE == 1) ? 16 * s : 0);
        const int hoff = (MODE == 0) ? 0 : (MODE == 1 ? h * 192 : h * 256), hoffv = (MODE == 0) ? 0 : h * 256;
        const bf16* kb = (MODE == 1) ? P.k + (size_t)((b * 16 + h) * SEQ) * P.ks : P.k + row0 * P.ks + hoff;
        const bf16* vb = P.v + row0 * P.vs + hoffv;
        bf16x8 qf[NSUB][KK];
#pragma unroll
        for (int s = 0; s < NSUB; ++s) { const bf16* qp = P.q + (row0 + tqs[s]) * P.qs + ((MODE == 0) ? (2 * w + s) * 128 : hoff) + 8 * g;
#pragma unroll
            for (int kk = 0; kk < KK; ++kk) qf[s][kk] = *(const bf16x8*)(qp + kk * 32); }
        float qnorm[NSUB];
#pragma unroll
        for (int s = 0; s < NSUB; ++s) qnorm[s] = 0.f;
        if (MODE == 0) {
            f32x4 qg8[KK][2];
#pragma unroll
            for (int kk = 0; kk < KK; ++kk) { qg8[kk][0] = *(const f32x4*)(P.gn + kk * 32 + 8 * g); qg8[kk][1] = *(const f32x4*)(P.gn + kk * 32 + 8 * g + 4); }
#pragma unroll
            for (int s = 0; s < NSUB; ++s) { float qv[KK][8]; float ss = 0.f;
#pragma unroll
                for (int kk = 0; kk < KK; ++kk) { const u32x4 wq = __builtin_bit_cast(u32x4, qf[s][kk]);
#pragma unroll
                    for (int e = 0; e < 4; ++e) { qv[kk][2 * e] = bflo(wq[e]); qv[kk][2 * e + 1] = bfhi(wq[e]); ss += qv[kk][2 * e] * qv[kk][2 * e] + qv[kk][2 * e + 1] * qv[kk][2 * e + 1]; } }
                ss = xsum32(xsum16(ss)); const float rstd = rsqrtf(ss * (1.0f / 128.0f) + NORM_EPS);
                float q2 = 0.f;
#pragma unroll
                for (int kk = 0; kk < KK; ++kk) { const f32x4 ga = qg8[kk < 4 ? kk : 0][0], gb = qg8[kk < 4 ? kk : 0][1]; u32x4 wq;
#pragma unroll
                    for (int e = 0; e < 8; ++e) { qv[kk][e] *= rstd * (e < 4 ? ga[e & 3] : gb[e & 3]); q2 += qv[kk][e] * qv[kk][e]; }
                    wq.x = pk2(qv[kk][0] * QC1, qv[kk][1] * QC1); wq.y = pk2(qv[kk][2] * QC1, qv[kk][3] * QC1); wq.z = pk2(qv[kk][4] * QC1, qv[kk][5] * QC1); wq.w = pk2(qv[kk][6] * QC1, qv[kk][7] * QC1); qf[s][kk] = __builtin_bit_cast(bf16x8, wq); }
                qnorm[s] = sqrtf(xsum32(xsum16(q2))); } }
        if (MODE == 1) {
#pragma unroll
            for (int s = 0; s < NSUB; ++s) { float qv[KK][8]; float ss = 0.f;
#pragma unroll
                for (int kk = 0; kk < KK; ++kk) { const u32x4 wq = __builtin_bit_cast(u32x4, qf[s][kk]);
#pragma unroll
                    for (int e = 0; e < 4; ++e) { qv[kk][2 * e] = bflo(wq[e]); qv[kk][2 * e + 1] = bfhi(wq[e]); ss += qv[kk][2 * e] * qv[kk][2 * e] + qv[kk][2 * e + 1] * qv[kk][2 * e + 1]; } }
                ss = xsum32(xsum16(ss)); const float rstd = rsqrtf(ss * (1.0f / 192.0f) + NORM_EPS); const float fp = (float)P.pos[row0 + tqs[s]];
#pragma unroll
                for (int kk = 0; kk < KK; ++kk) { const f32x4 ga = *(const f32x4*)(P.gn + kk * 32 + 8 * g), gb = *(const f32x4*)(P.gn + kk * 32 + 8 * g + 4);
#pragma unroll
                    for (int e = 0; e < 8; ++e) qv[kk][e] *= rstd * (e < 4 ? ga[e & 3] : gb[e & 3]); }
#pragma unroll
                for (int e = 0; e < 8; ++e) { const float inv = exp2f(-(float)(8 * g + e) * (13.287712379549449f / 32.0f)); float tr = fp * inv * 0.15915494309189535f; tr = tr - floorf(tr);
                    const float sn = __builtin_amdgcn_sinf(tr), cs = __builtin_amdgcn_cosf(tr), y1 = qv[4][e], y2 = qv[5][e]; qv[4][e] = y1 * cs - y2 * sn; qv[5][e] = y1 * sn + y2 * cs; }
                float q2 = 0.f;
#pragma unroll
                for (int kk = 0; kk < KK; ++kk) { u32x4 wq; wq.x = pk2(qv[kk][0] * QC1, qv[kk][1] * QC1); wq.y = pk2(qv[kk][2] * QC1, qv[kk][3] * QC1); wq.z = pk2(qv[kk][4] * QC1, qv[kk][5] * QC1); wq.w = pk2(qv[kk][6] * QC1, qv[kk][7] * QC1); qf[s][kk] = __builtin_bit_cast(bf16x8, wq);
#pragma unroll
                    for (int e = 0; e < 8; ++e) q2 += qv[kk][e] * qv[kk][e];
                    asm volatile("" : "+v"(qf[s][kk])); }
                qnorm[s] = sqrtf(xsum32(xsum16(q2))); } }
        float c1, slope2[NSUB], cst[NSUB], lg = 0.f; int pos_t = 0;
#pragma unroll
        for (int s = 0; s < NSUB; ++s) cst[s] = 0.f;
        if (MODE == 0) { c1 = 0.08838834764831845f * 1.4426950408889634f; pos_t = P.pos[row0 + tqs[0]];
#pragma unroll
            for (int s = 0; s < NSUB; ++s) slope2[s] = __builtin_amdgcn_exp2f(-0.5f * (float)(2 * w + s + 1)) * 1.4426950408889634f; }
        else if (MODE == 1) { c1 = 0.07216878364870322f * 1.4426950408889634f;
            float gm = fmaxf(fmaxf(fabsf(P.gk[l]), fabsf(P.gk[64 + l])), fabsf(P.gk[128 + l]));
#pragma unroll
            for (int o_ = 1; o_ < 64; o_ <<= 1) gm = fmaxf(gm, shx(gm, o_, l));
#pragma unroll
            for (int s = 0; s < NSUB; ++s) { slope2[s] = 0.f; cst[s] = -(qnorm[s] * 13.86f * gm * 1.01f) * c1; } }
        else { c1 = 0.0625f; slope2[0] = 0.f; lg = log2f(1.0f - exp2f(-5.0f - (float)h)); }
        f32x4 o[NSUB][NDT], ol[NSUB];
#pragma unroll
        for (int s = 0; s < NSUB; ++s) { ol[s] = (f32x4){0.f, 0.f, 0.f, 0.f};
#pragma unroll
            for (int dt = 0; dt < NDT; ++dt) o[s][dt] = (f32x4){0.f, 0.f, 0.f, 0.f}; }
        if (MODE == 0) { unsigned mw[2]; int pw[4];
#pragma unroll
                         for (int k = 0; k < 2; ++k) { const int i = tid + NT * k; mw[k] = P.mask[(row0 + tq0 + (i >> 6)) * 64 + (i & 63)]; }
#pragma unroll
                         for (int k = 0; k < 4; ++k) pw[k] = P.pos[row0 + tid + NT * k];
                         asm volatile("" : "+v"(mw[0]), "+v"(mw[1]), "+v"(pw[0]), "+v"(pw[1]), "+v"(pw[2]), "+v"(pw[3]));
#pragma unroll
                         for (int k = 0; k < 2; ++k) mlds[tid + NT * k] = mw[k];
#pragma unroll
                         for (int k = 0; k < 4; ++k) plds[tid + NT * k] = pw[k]; }
        constexpr int KB_OFF = 16384;
        const int r4 = l >> 4, s16 = l & 15, r8 = l >> 3, s8 = l & 7;
        const unsigned laneKA = (unsigned)(r4 * P.ks + ((s16 ^ (4 * (w & 3) + r4)) << 3));
        const unsigned laneKB = (unsigned)(r8 * P.ks + 128 + ((s8 ^ (4 * (w & 1) + (r8 >> 1))) << 3));
        const unsigned laneV = (unsigned)(r4 * P.vs + (((s16 >> 1) ^ (4 * (w & 1) + r4)) << 4) + ((s16 & 1) << 3));
        constexpr int JV0 = NPW - 2;
        unsigned kxa[4], kxb[2], vx[NDT];
#pragma unroll
        for (int kk = 0; kk < 4; ++kk) kxa[kk] = (unsigned)(li * 256 + (((kk * 4 + g) ^ li) << 4));
#pragma unroll
        for (int i = 0; i < 2; ++i) kxb[i] = (unsigned)(KB_OFF + li * 128 + (((i * 4 + g) ^ (li >> 1)) << 4));
#pragma unroll
        for (int dt = 0; dt < NDT; ++dt) vx[dt] = (unsigned)(KT + (4 * g + (li >> 2)) * 256 + ((dt ^ (4 * (g & 1) + (li >> 2))) << 5) + (li & 3) * 8);
#define ATT_DMA(kt_, buf_) do { const bf16* tk_ = kb + (size_t)(kt_) * 64 * P.ks; const bf16* tv_ = vb + (size_t)(kt_) * 64 * P.vs; const unsigned bb_ = lds0 + (unsigned)(buf_) * BUFB; \
        _Pragma("unroll") for (int j = 0; j < NPW; ++j) { \
            if (j < 2) { const int pa = w + 8 * j; glds16(tk_ + (size_t)(4 * pa) * P.ks + laneKA, (unsigned)__builtin_amdgcn_readfirstlane(bb_ + pa * 1024)); } \
            else if (j < JV0) { glds16(tk_ + (size_t)(8 * w) * P.ks + laneKB, (unsigned)__builtin_amdgcn_readfirstlane(bb_ + KB_OFF + w * 1024)); } \
            else { const int pv = w + 8 * (j - JV0); glds16(tv_ + (size_t)(4 * pv) * P.vs + laneV, (unsigned)__builtin_amdgcn_readfirstlane(bb_ + KT + pv * 1024)); } } } while (0)
        ATT_DMA(0, 0);
        if (nkt > 1) { ATT_DMA(1, 1); if (NPW == 4) ATT_WAIT_BAR(4); else ATT_WAIT_BAR(5); } else ATT_WAIT_BAR(0);
        if (MODE == 0) {
            float gm = fmaxf(fabsf(P.gk[l]), fabsf(P.gk[64 + l]));
#pragma unroll
            for (int o_ = 1; o_ < 64; o_ <<= 1) gm = fmaxf(gm, shx(gm, o_, l));
            int wi = tqs[0] >> 5; unsigned wd = mlds[li * 64 + wi];
            while (wd == 0u && wi > 0) { --wi; wd = mlds[li * 64 + wi]; }
            const int smax = wi * 32 + 31 - __builtin_clz(wd | 1u);
            const float dmin = (float)(pos_t - plds[smax]);
#pragma unroll
            for (int s = 0; s < NSUB; ++s) cst[s] = -c1 * (qnorm[s] * 11.3137085f * gm * 1.01f) + slope2[s] * dmin;
        }
        if (w >= 4) __builtin_amdgcn_s_setprio(1);
        int bcur = 0, bnxt2 = 2;
        for (int kt = 0; kt < nkt; ++kt) {
            const bool more2 = (kt + 2 < nkt);
            if (more2) ATT_DMA(kt + 2, bnxt2);
            const LAS unsigned char* Kb = lds + bcur * BUFB; const LAS unsigned char* Vb = Kb + KT;
            bool active = true, need_mask = true;
            if (MODE != 0) { const int k0 = kt * 64; active = (k0 <= qbase + QPW - 1); need_mask = (k0 + 63 > qbase); }
            if (active) {
                f32x4 st2[2][NSUB][2]; bf16x8 pf2[2][NSUB]; float xs[NSUB][8];
                float dist[8]; unsigned em[8] = {0xffffffffu, 0xffffffffu, 0xffffffffu, 0xffffffffu, 0xffffffffu, 0xffffffffu, 0xffffffffu, 0xffffffffu};
                constexpr int NQ = 2 * KK, NE = NSUB * 8;
                auto k_read = [&](const int n) __attribute__((always_inline)) -> bf16x8 {
                    const int h32 = n / NQ, i = n % NQ, t16 = i / KK, kk = i % KK;
                    return (kk < 4) ? *(const LAS bf16x8*)(Kb + (h32 * 2 + t16) * 4096 + kxa[kk < 4 ? kk : 0]) : *(const LAS bf16x8*)(Kb + (h32 * 2 + t16) * 2048 + kxb[kk < 4 ? 0 : kk - 4]); };
                auto qk_mma = [&](const int n, const bf16x8 a) __attribute__((always_inline)) { const int h32 = n / NQ, i = n % NQ, t16 = i / KK, kk = i % KK;
#pragma unroll
                    for (int s = 0; s < NSUB; ++s) st2[h32][s][t16] = MFMA16(a, qf[s][kk], st2[h32][s][t16]); };
                auto sm_pre = [&](const int h32) __attribute__((always_inline)) {
                    if (MODE == 0) { const int key0 = kt * 64 + h32 * 32 + 4 * g; const i32x4 p0 = *(const LAS i32x4*)(plds + key0), p1 = *(const LAS i32x4*)(plds + key0 + 16);
#pragma unroll
                        for (int e = 0; e < 4; ++e) { dist[e] = (float)(pos_t - p0[e]); dist[4 + e] = (float)(pos_t - p1[e]); }
                        const unsigned t = mlds[li * 64 + kt * 2 + h32] >> (4 * g);
#pragma unroll
                        for (int e = 0; e < 8; ++e) em[e] = (unsigned)__builtin_amdgcn_sbfe((int)t, (e >> 2) * 16 + (e & 3), 1); } };
                auto sm_elem = [&](const int h32, const int j) __attribute__((always_inline)) {
                    const int s = j >> 3, e = j & 7; const int key0 = kt * 64 + h32 * 32 + 4 * g; const float raw = st2[h32][s][e >> 2][e & 3]; float x;
                    if (MODE == 0) { const unsigned vb_ = __float_as_uint(raw - slope2[s] * dist[e]); x = __uint_as_float((vb_ & em[e]) | (~em[e] & 0xff800000u)); }
                    else if (MODE == 1) { const int key = key0 + (e >> 2) * 16 + (e & 3); x = (need_mask && key > tqs[s]) ? NEG_INF : raw; }
                    else { const int d = tqs[s] - (key0 + (e >> 2) * 16 + (e & 3)); const float v = raw * c1 * __builtin_amdgcn_exp2f((float)d * lg); x = (d >= 0) ? v : 0.f; }
                    if (MODE != 2) x = __builtin_amdgcn_exp2f(x);
                    xs[s][e] = x; };
                auto sm_fin = [&](const int h32) __attribute__((always_inline)) {
#pragma unroll
                    for (int s = 0; s < NSUB; ++s) { u32x4 pw; pw.x = pk2(xs[s][0], xs[s][1]); pw.y = pk2(xs[s][2], xs[s][3]); pw.z = pk2(xs[s][4], xs[s][5]); pw.w = pk2(xs[s][6], xs[s][7]);
                        pf2[h32][s] = __builtin_bit_cast(bf16x8, pw);
                        if (MODE != 2) ol[s] = MFMA16(ones8, pf2[h32][s], ol[s]); } };
                auto v_read = [&](const int m) __attribute__((always_inline)) -> bf16x8 { const LAS unsigned char* vp = Kb + (m / NDT) * 8192 + vx[m % NDT]; return cat8(tr_read(vp), tr_read(vp + 4096)); };
                auto pv_mma = [&](const int m, const bf16x8 a) __attribute__((always_inline)) {
#pragma unroll
                    for (int s = 0; s < NSUB; ++s) o[s][m % NDT] = MFMA16(a, pf2[m / NDT][s], o[s][m % NDT]); };
#pragma unroll
                for (int h = 0; h < 2; ++h)
#pragma unroll
                    for (int s = 0; s < NSUB; ++s) { const float c0 = (MODE != 2) ? cst[s] : 0.f; st2[h][s][0] = (f32x4){c0, c0, c0, c0}; st2[h][s][1] = (f32x4){c0, c0, c0, c0}; }
                bf16x8 kf[3], vf[2];
                kf[0] = k_read(0); kf[1] = k_read(1);
#pragma unroll
                for (int n = 0; n < 2 * NQ; ++n) {
                    if (n + 2 < 2 * NQ) kf[(n + 2) % 3] = k_read(n + 2);
                    if (n == NQ) sm_pre(0);
                    qk_mma(n, kf[n % 3]);
                    if (n >= NQ) {
#pragma unroll
                        for (int j = ((n - NQ) * NE) / NQ; j < ((n - NQ + 1) * NE) / NQ; ++j) sm_elem(0, j); }
                    __builtin_amdgcn_sched_barrier(0); }
                vf[0] = v_read(0);
                sm_fin(0);
                __builtin_amdgcn_sched_barrier(0);
                sm_pre(1);
#pragma unroll
                for (int m = 0; m < 2 * NDT; ++m) {
                    if (m + 1 < 2 * NDT) vf[(m + 1) & 1] = v_read(m + 1);
                    if (m == NDT) sm_fin(1);
                    pv_mma(m, vf[m & 1]);
                    if (m < NDT) {
#pragma unroll
                        for (int j = (m * NE) / NDT; j < ((m + 1) * NE) / NDT; ++j) sm_elem(1, j); }
                    __builtin_amdgcn_sched_barrier(0); }
            }
            if (more2) { if (NPW == 4) ATT_WAIT_BAR(4); else ATT_WAIT_BAR(5); } else ATT_WAIT_BAR(0);
            bcur = (bcur == NBUF - 1) ? 0 : bcur + 1; bnxt2 = (bnxt2 == NBUF - 1) ? 0 : bnxt2 + 1;
        }
#undef ATT_DMA
        __builtin_amdgcn_s_setprio(0);
        u32x2 gwv[NSUB][NDT];
#pragma unroll
        for (int s = 0; s < NSUB; ++s) { const size_t row = row0 + tqs[s]; const int hcol = (MODE == 0) ? (2 * w + s) * 128 : (MODE == 1 ? h * 128 : h * 256);
#pragma unroll
            for (int dt = 0; dt < NDT; ++dt) gwv[s][dt] = *(const u32x2*)(P.gate + row * P.gs + hcol + dt * 16 + 4 * g); }
        static_assert(NSUB * NDT == 16, "gate batch");
        asm volatile("" : "+v"(gwv[0][0]), "+v"(gwv[0][1]), "+v"(gwv[0][2]), "+v"(gwv[0][3]), "+v"(gwv[0][4]), "+v"(gwv[0][5]), "+v"(gwv[0][6]), "+v"(gwv[0][7]),
                          "+v"(gwv[NSUB - 1][NDT - 8]), "+v"(gwv[NSUB - 1][NDT - 7]), "+v"(gwv[NSUB - 1][NDT - 6]), "+v"(gwv[NSUB - 1][NDT - 5]), "+v"(gwv[NSUB - 1][NDT - 4]), "+v"(gwv[NSUB - 1][NDT - 3]), "+v"(gwv[NSUB - 1][NDT - 2]), "+v"(gwv[NSUB - 1][NDT - 1]));
#pragma unroll
        for (int s = 0; s < NSUB; ++s) {
            const size_t row = row0 + tqs[s];
            float inv = 1.f, mean = 0.f;
            if (MODE != 2) inv = 1.0f / ol[s][0];
            else { float s1 = 0.f;
#pragma unroll
                for (int dt = 0; dt < NDT; ++dt) s1 += (o[s][dt][0] + o[s][dt][1]) + (o[s][dt][2] + o[s][dt][3]);
                s1 = xsum32(xsum16(s1)); mean = s1 * (1.0f / 256.0f); float s2 = 0.f;
#pragma unroll
                for (int dt = 0; dt < NDT; ++dt)
#pragma unroll
                    for (int e = 0; e < 4; ++e) { const float d = o[s][dt][e] - mean; s2 += d * d; }
                s2 = xsum32(xsum16(s2)); inv = rsqrtf(s2 * (1.0f / 256.0f) + NORM_EPS); }
            const int hcol = (MODE == 0) ? (2 * w + s) * 128 : (MODE == 1 ? h * 128 : h * 256);
#pragma unroll
            for (int dt = 0; dt < NDT; ++dt) { const int col = hcol + dt * 16 + 4 * g;
                const u32x2 gw = gwv[s][dt];
                float y[4];
#pragma unroll
                for (int e = 0; e < 4; ++e) { const float gv = (e & 1) ? bfhi(gw[e >> 1]) : bflo(gw[e >> 1]); float v = (o[s][dt][e] - mean) * inv; if (MODE == 2) v *= P.gn[col + e]; y[e] = v * fsilu(gv); }
                *(unsigned*)(P.mix + row * DM + col) = pg8::cvt_pk4_fp8(y[0] * MIX8_SCALE, y[1] * MIX8_SCALE, y[2] * MIX8_SCALE, y[3] * MIX8_SCALE); }
        }
    }
}

constexpr int RC_Q = 0, RC_K = 32768, RC_V = 65536, RC_ST = 81920, RC_STP = 528;
static_assert(RC_ST + 64 * RC_STP <= RING_BYTES, "retention LDS");
__device__ __forceinline__ void retention_chunk_phase(Frame& F, const bf16* Z, bf16* RAW) {
    OPAQUE_TID();
    const int tid = F.tid, l = F.lane, w = F.wave, li = l & 15, g = l >> 4;
    LAS unsigned char* lds = F.lds;
    for (int u = F.vc; u < 256; u += F.G) {
        const int b = u >> 5, h = (u >> 2) & 7, es = u & 3;
        const float lg = log2f(1.0f - exp2f(-5.0f - (float)h));
        const bf16* qsrc = Z + (size_t)b * SEQ * LDZE + ZE_QB + h * 256;
        const bf16* ksrc = Z + (size_t)b * SEQ * LDZE + ZE_KB + h * 256;
        const bf16* vsrc = Z + (size_t)b * SEQ * LDZE + ZE_VB + h * 256 + es * 64;
        const int mrow = (tid & 255) >> 1;
        const unsigned goff0 = (unsigned)(mrow * LDZE + (tid >> 8) * 16 + (tid & 1) * 8);
        { u32x4 z4 = {0u, 0u, 0u, 0u}; asm volatile("" : "+v"(z4));
          for (int i = tid; i < 64 * RC_STP / 16; i += NT) *(LAS u32x4*)(lds + RC_ST + i * 16) = z4; }
        f32x4 S[2][4];
#pragma unroll
        for (int hf = 0; hf < 2; ++hf)
#pragma unroll
            for (int et = 0; et < 4; ++et) S[hf][et] = (f32x4){0.f, 0.f, 0.f, 0.f};
        const float g128 = __builtin_amdgcn_exp2f(128.0f * lg);
        u32x4 qreg[4], kreg[4], vreg[2];
#define RC_LOAD_QK(ck_, hf_) do { const bf16* q_ = qsrc + (size_t)(ck_) * 128 * LDZE + (hf_) * 128; const bf16* k_ = ksrc + (size_t)(ck_) * 128 * LDZE + (hf_) * 128; \
        _Pragma("unroll") for (int r = 0; r < 4; ++r) { qreg[r] = *(const u32x4*)(q_ + r * 32 + goff0); kreg[r] = *(const u32x4*)(k_ + r * 32 + goff0); } } while (0)
#define RC_LOAD_V(ck_) do { const bf16* v_ = vsrc + (size_t)(ck_) * 128 * LDZE; _Pragma("unroll") for (int r = 0; r < 2; ++r) vreg[r] = *(const u32x4*)(v_ + r * 32 + goff0); } while (0)
#define RC_STORE_QK() do { const float km_ = __builtin_amdgcn_exp2f(-(float)mrow * lg); _Pragma("unroll") for (int r = 0; r < 4; ++r) { *(LAS u32x4*)(lds + RC_Q + r * 8192 + tid * 16) = qreg[r]; u32x4 kw_;   \
        _Pragma("unroll") for (int e_ = 0; e_ < 4; ++e_) kw_[e_] = pk2(bflo(kreg[r][e_]) * km_, bfhi(kreg[r][e_]) * km_); \
        *(LAS u32x4*)(lds + RC_K + r * 8192 + tid * 16) = kw_; } } while (0)
#define RC_STORE_V() do { _Pragma("unroll") for (int r = 0; r < 2; ++r) *(LAS u32x4*)(lds + RC_V + r * 8192 + tid * 16) = vreg[r]; } while (0)
        RC_LOAD_QK(0, 0); RC_LOAD_V(0);
#pragma unroll 1
        for (int ck = 0; ck < 16; ++ck) {
            int go = g, lo_ = li; asm volatile("" : "+v"(go), "+v"(lo_));
            f32x4 st[8], cross[4];
#pragma unroll
            for (int mt = 0; mt < 8; ++mt) st[mt] = (f32x4){0.f, 0.f, 0.f, 0.f};
#pragma unroll
            for (int et = 0; et < 4; ++et) cross[et] = (f32x4){0.f, 0.f, 0.f, 0.f};
#pragma unroll
            for (int hf = 0; hf < 2; ++hf)
#pragma unroll
                for (int et = 0; et < 4; ++et) S[hf][et] = S[hf][et] * g128;
#pragma unroll
            for (int hf = 0; hf < 2; ++hf) {
                RC_STORE_QK(); if (hf == 0) RC_STORE_V();
                __syncthreads();
                if (hf == 0) RC_LOAD_QK(ck, 1); else if (ck + 1 < 16) { RC_LOAD_QK(ck + 1, 0); RC_LOAD_V(ck + 1); }
                auto rc_frag = [&](const int k) __attribute__((always_inline)) -> bf16x8 {
                    if (k < 36) { const int kk = k / 9, r = k % 9;
                        if (r == 0) return *(const LAS bf16x8*)(lds + RC_Q + (2 * kk + (g >> 1)) * 4096 + (16 * w + li) * 32 + (g & 1) * 16);
                        return *(const LAS bf16x8*)(lds + RC_K + (2 * kk + (g >> 1)) * 4096 + (16 * (r - 1) + li) * 32 + (g & 1) * 16); }
                    if (k < 56) { const int i = k - 36, kk = i / 5, r = i % 5;
                        if (r == 0) return *(const LAS bf16x8*)(lds + RC_Q + (2 * kk + (g >> 1)) * 4096 + (16 * w + li) * 32 + (g & 1) * 16);
                        return *(const LAS bf16x8*)(lds + RC_ST + (16 * (r - 1) + li) * RC_STP + (128 * hf + 32 * kk + 8 * g) * 2); }
                    const int i = k - 56, ms = i / 5, r = i % 5;
                    if (r == 0) { const LAS unsigned char* kp = lds + RC_K + w * 4096 + (32 * ms + 8 * g + (li >> 2)) * 32 + (li & 3) * 8; return cat8(tr_read(kp), tr_read(kp + 128)); }
                    const LAS unsigned char* vp = lds + RC_V + (r - 1) * 4096 + (32 * ms + 8 * g + (li >> 2)) * 32 + (li & 3) * 8; return cat8(tr_read(vp), tr_read(vp + 128)); };
                constexpr int RPD = 5, NST = 76;
                bf16x8 fr[RPD + 1];
#pragma unroll
                for (int k = 0; k < RPD; ++k) fr[k] = rc_frag(k);
                bf16x8 ocur = fr[0];
#pragma unroll
                for (int k = 0; k < NST; ++k) {
                    if (k + RPD < NST) fr[(k + RPD) % (RPD + 1)] = rc_frag(k + RPD);
                    const bf16x8 f = fr[k % (RPD + 1)];
                    if (k < 36) { if (k % 9 == 0) ocur = f; else st[k % 9 - 1] = MFMA16(f, ocur, st[k % 9 - 1]); }
                    else if (k < 56) { if ((k - 36) % 5 == 0) ocur = f; else cross[(k - 36) % 5 - 1] = MFMA16(ocur, f, cross[(k - 36) % 5 - 1]); }
                    else { if ((k - 56) % 5 == 0) ocur = f; else S[hf][(k - 56) % 5 - 1] = MFMA16(ocur, f, S[hf][(k - 56) % 5 - 1]); }
                    __builtin_amdgcn_sched_barrier(0); }
                __syncthreads();
            }
            const int n = 16 * w + lo_; const float cn = __builtin_amdgcn_exp2f((float)n * lg) * 0.0625f;
            f32x4 inner[4];
#pragma unroll
            for (int et = 0; et < 4; ++et) inner[et] = (f32x4){0.f, 0.f, 0.f, 0.f};
#pragma unroll
            for (int ms = 0; ms < 4; ++ms) {
                float p[8];
#pragma unroll
                for (int e = 0; e < 8; ++e) { const int m = 32 * ms + (e >> 2) * 16 + 4 * go + (e & 3); const float v = st[2 * ms + (e >> 2)][e & 3] * cn; p[e] = (m <= n) ? v : 0.f; }
                u32x4 pw; pw.x = pk2(p[0], p[1]); pw.y = pk2(p[2], p[3]); pw.z = pk2(p[4], p[5]); pw.w = pk2(p[6], p[7]);
                const bf16x8 pa = __builtin_bit_cast(bf16x8, pw);
#pragma unroll
                for (int et = 0; et < 4; ++et) { const LAS unsigned char* vp = lds + RC_V + et * 4096 + (32 * ms + 4 * g + (li >> 2)) * 32 + (li & 3) * 8;
                    const bf16x8 vb8 = cat8(tr_read(vp), tr_read(vp + 512)); inner[et] = MFMA16(pa, vb8, inner[et]); }
                __builtin_amdgcn_sched_barrier(0);
            }
            {
                bf16* orow = RAW + ((size_t)b * SEQ + ck * 128 + 16 * w + 4 * g) * 2048 + h * 256 + es * 64 + li;
#pragma unroll
                for (int r = 0; r < 4; ++r) { const float qd = __builtin_amdgcn_exp2f((float)(16 * w + 4 * go + r + 1 + 127) * lg) * 0.0625f;
#pragma unroll
                    for (int et = 0; et < 4; ++et) { const float o = inner[et][r] + qd * cross[et][r]; orow[(size_t)r * 2048 + et * 16] = (bf16)(pk2(o, 0.f) & 0xffffu); } }
            }
#pragma unroll
            for (int hf = 0; hf < 2; ++hf)
#pragma unroll
                for (int et = 0; et < 4; ++et) { u32x2 sw; sw.x = pk2(S[hf][et][0], S[hf][et][1]); sw.y = pk2(S[hf][et][2], S[hf][et][3]);
                    *(LAS u32x2*)(lds + RC_ST + (16 * et + li) * RC_STP + (128 * hf + 16 * w + 4 * g) * 2) = sw; }
            __syncthreads();
        }
#undef RC_LOAD_QK
#undef RC_LOAD_V
#undef RC_STORE_QK
#undef RC_STORE_V
    }
}
__device__ __forceinline__ void ret_finish_phase(Frame& F, const bf16* RAW, const bf16* Z, const float* gn, unsigned char* MIX) {
    OPAQUE_TID();
    const int gw = F.c * NWAVES + F.wave, NGW = F.G * NWAVES, l = F.lane;
    u32x4 cur[8], nxt[8];
#define RF_LOAD(dst, m_) do { _Pragma("unroll") for (int j = 0; j < 4; ++j) { dst[j] = ((const u32x4*)(RAW + (size_t)(m_) * 2048 + 32 * l))[j]; dst[4 + j] = ((const u32x4*)(Z + (size_t)(m_) * LDZE + ZE_GB + 32 * l))[j]; } } while (0)
    f32x4 gg8[8];
#pragma unroll
    for (int j = 0; j < 8; ++j) gg8[j] = ((const f32x4*)(gn + 32 * l))[j];
    if (gw < MROWS) RF_LOAD(cur, gw);
    for (int m = gw; m < MROWS; m += NGW) {
        if (m + NGW < MROWS) RF_LOAD(nxt, m + NGW);
        float v[32]; float s1 = 0.f;
#pragma unroll
        for (int j = 0; j < 4; ++j)
#pragma unroll
            for (int e = 0; e < 4; ++e) { v[8 * j + 2 * e] = bflo(cur[j][e]); v[8 * j + 2 * e + 1] = bfhi(cur[j][e]); }
#pragma unroll
        for (int e = 0; e < 32; ++e) s1 += v[e];
        s1 += shx(s1, 1, l); s1 += shx(s1, 2, l); s1 += shx(s1, 4, l);
        const float mean = s1 * (1.0f / 256.0f); float s2 = 0.f;
#pragma unroll
        for (int e = 0; e < 32; ++e) { const float d = v[e] - mean; s2 += d * d; }
        s2 += shx(s2, 1, l); s2 += shx(s2, 2, l); s2 += shx(s2, 4, l);
        const float rstd = rsqrtf(s2 * (1.0f / 256.0f) + NORM_EPS);
        unsigned* o = (unsigned*)(MIX + (size_t)m * DM + 2048 + 32 * l);
#pragma unroll
        for (int j = 0; j < 8; ++j) { const f32x4 gg = gg8[j]; float y[4];
#pragma unroll
            for (int e = 0; e < 4; ++e) { const unsigned gwd = cur[4 + (j >> 1)][(j & 1) * 2 + (e >> 1)]; const float gv = (e & 1) ? bfhi(gwd) : bflo(gwd); y[e] = (v[4 * j + e] - mean) * rstd * gg[e] * fsilu(gv) * MIX8_SCALE; }
            o[j] = pg8::cvt_pk4_fp8(y[0], y[1], y[2], y[3]); }
#pragma unroll
        for (int j = 0; j < 8; ++j) cur[j] = nxt[j];
    }
#undef RF_LOAD
}

__device__ __forceinline__ void gmlp_phase(Frame& F, const bf16* Z, const float* STATS, const bf16* CWS, const float* cbs, const float* vgain, unsigned char* MIX) {
    OPAQUE_TID();
    const int tid = F.tid, l = F.lane, w = F.wave, li = l & 15, gq = l >> 4;
    LAS unsigned char* Vl = F.lds;
    const int srow = (tid & 255) >> 1, c80 = (tid >> 8) * 2 + (tid & 1);
    u32x4 vcur[4], vnxt[4]; f32x2 scur, snxt;
#define GM_LOAD(dv, ds, u_) do { const int bc_ = (u_) >> 4, g_ = (u_) & 15; const bf16* zp_ = Z + ((size_t)bc_ * 128 + srow) * LDZO + ZO_CV + g_ * 128 + c80 * 8; \
        _Pragma("unroll") for (int r4 = 0; r4 < 4; ++r4) dv[r4] = *(const u32x4*)(zp_ + r4 * 32); ds = *(const f32x2*)(STATS + 2 * ((size_t)bc_ * 128 + srow)); } while (0)
    if (F.c < 2048) GM_LOAD(vcur, scur, F.c);
    for (int r = 0;; ++r) {
        const int u = r * F.G + F.c; if (u >= 2048) break;
        const int bc = u >> 4, g = u & 15; const size_t m0 = (size_t)bc * 128;
        const int t = 16 * w + li, kkmax = (16 * w + 15) >> 5; const size_t row = m0 + t;
        const bf16* wrow = CWS + ((size_t)g * 128 + t) * 128 + 8 * gq;
        bf16x8 bw[4];
#pragma unroll
        for (int kk = 0; kk < 4; ++kk) bw[kk] = *(const bf16x8*)(wrow + kk * 32);
        u32x2 cu[8], gc[8];
#pragma unroll
        for (int dt = 0; dt < 8; ++dt) { const int col = g * 128 + dt * 16 + 4 * gq; cu[dt] = *(const u32x2*)(Z + row * LDZO + ZO_CU + col); gc[dt] = *(const u32x2*)(Z + row * LDZO + ZO_GC + col); }
        const float bias = cbs[g * 128 + t];
        f32x4 vg[4][2];
#pragma unroll
        for (int r4 = 0; r4 < 4; ++r4) { const int c8 = c80 + 4 * r4; vg[r4][0] = *(const f32x4*)(vgain + g * 128 + c8 * 8); vg[r4][1] = *(const f32x4*)(vgain + g * 128 + c8 * 8 + 4); }
        asm volatile("" : "+v"(vg[0][0]), "+v"(vg[0][1]), "+v"(vg[1][0]), "+v"(vg[1][1]), "+v"(vg[2][0]), "+v"(vg[2][1]), "+v"(vg[3][0]), "+v"(vg[3][1]));
#pragma unroll
        for (int r4 = 0; r4 < 4; ++r4) {
            const f32x4 ga = vg[r4][0], gb = vg[r4][1];
            float y[8];
#pragma unroll
            for (int e = 0; e < 4; ++e) { y[2 * e] = (fgelu(bflo(vcur[r4][e])) - scur.x) * scur.y; y[2 * e + 1] = (fgelu(bfhi(vcur[r4][e])) - scur.x) * scur.y; }
            u32x4 ow; ow.x = pk2(y[0] * ga[0], y[1] * ga[1]); ow.y = pk2(y[2] * ga[2], y[3] * ga[3]); ow.z = pk2(y[4] * gb[0], y[5] * gb[1]); ow.w = pk2(y[6] * gb[2], y[7] * gb[3]);
            *(LAS u32x4*)(Vl + (tid + NT * r4) * 16) = ow; }
        __syncthreads();
        const int un = u + F.G;
        if (un < 2048) GM_LOAD(vnxt, snxt, un);
        f32x4 acc[8];
#pragma unroll
        for (int dt = 0; dt < 8; ++dt) acc[dt] = (f32x4){0.f, 0.f, 0.f, 0.f};
#pragma unroll
        for (int kk = 0; kk < 4; ++kk) if (kk <= kkmax) {
#pragma unroll
            for (int dt = 0; dt < 8; ++dt) { const LAS unsigned char* vp = Vl + dt * 4096 + (kk * 32 + 8 * gq + (li >> 2)) * 32 + (li & 3) * 8;
                const bf16x8 a = cat8(tr_read(vp), tr_read(vp + 128)); acc[dt] = MFMA16(a, bw[kk], acc[dt]); } }
#pragma unroll
        for (int dt = 0; dt < 8; ++dt) { const int col = g * 128 + dt * 16 + 4 * gq;
            float y[4];
#pragma unroll
            for (int e = 0; e < 4; ++e) { const float uv = (e & 1) ? bfhi(cu[dt][e >> 1]) : bflo(cu[dt][e >> 1]), gv = (e & 1) ? bfhi(gc[dt][e >> 1]) : bflo(gc[dt][e >> 1]); y[e] = fgelu(uv) * (acc[dt][e] + bias) * fsilu(gv); }
            *(unsigned*)(MIX + row * DM + col) = pg8::cvt_pk4_fp8(y[0] * MIX8_SCALE, y[1] * MIX8_SCALE, y[2] * MIX8_SCALE, y[3] * MIX8_SCALE); }
        __syncthreads();
#pragma unroll
        for (int r4 = 0; r4 < 4; ++r4) vcur[r4] = vnxt[r4];
        scur = snxt;
    }
#undef GM_LOAD
}

__device__ __forceinline__ void kr_phase(Frame& F, const unsigned char* H8, const unsigned char* W, const float* RSTD, bf16* Z) {
    OPAQUE_TID();
    const int l = F.lane, w = F.wave, fr = l & 15, fq = l >> 4;
    LAS f32x4* red = (LAS f32x4*)F.lds;
    for (int rb = F.c; rb < MROWS / 64; rb += F.G) {
        f32x4 acc[4][4];
#pragma unroll
        for (int m = 0; m < 4; ++m)
#pragma unroll
            for (int n = 0; n < 4; ++n) acc[m][n] = (f32x4){0.f, 0.f, 0.f, 0.f};
        const unsigned char* ap = H8 + (size_t)rb * 64 * DM;
        const unsigned char* bp = W;
        const unsigned lo = (unsigned)(fr * DM + w * 512 + fq * 32);
        pg8::i32x8 fa[2][4], fb[4];
#define KR_LOADA(s_, ks_) do { _Pragma("unroll") for (int m = 0; m < 4; ++m) { const unsigned char* p = ap + (lo + (unsigned)(m * 16 * DM + (ks_) * 128)); fa[s_][m] = pg8::cat_f8(*(const bf16x8*)p, *(const bf16x8*)(p + 16)); } } while (0)
#define KR_LOADB(ks_) do { _Pragma("unroll") for (int n = 0; n < 4; ++n) { const unsigned char* p = bp + (lo + (unsigned)(n * 16 * DM + (ks_) * 128)); fb[n] = pg8::cat_f8(*(const bf16x8*)p, *(const bf16x8*)(p + 16)); } } while (0)
        KR_LOADA(0, 0); KR_LOADB(0); KR_LOADA(1, 1);
#pragma unroll
        for (int ks = 0; ks < 4; ++ks) {
#pragma unroll
            for (int m = 0; m < 4; ++m)
#pragma unroll
                for (int n = 0; n < 4; ++n) asm volatile("v_mfma_f32_16x16x128_f8f6f4 %0, %1, %2, %0" : "+v"(acc[m][n]) : "v"(fb[n]), "v"(fa[ks & 1][m]));
            if (ks + 1 < 4) { asm volatile("s_nop 7" ::: "memory"); KR_LOADB(ks + 1); if (ks + 2 < 4) KR_LOADA(ks & 1, ks + 2); } }
#undef KR_LOADA
#undef KR_LOADB
        asm volatile("s_nop 15\n\ts_nop 15" ::: "memory");
#pragma unroll
        for (int m = 0; m < 4; ++m)
#pragma unroll
            for (int n = 0; n < 4; ++n) { asm volatile("" : "+v"(acc[m][n])); red[(w * 16 + m * 4 + n) * 64 + l] = acc[m][n]; }
        __syncthreads();
#pragma unroll
        for (int r2 = 0; r2 < 2; ++r2) { const int e = F.tid + 512 * r2, tile = e >> 6, ll = e & 63; f32x4 s = red[tile * 64 + ll];
#pragma unroll
            for (int ww = 1; ww < 8; ++ww) s = s + red[(ww * 16 + tile) * 64 + ll];
            const int row = rb * 64 + (tile >> 2) * 16 + (ll & 15), col = (tile & 3) * 16 + 4 * (ll >> 4); const float sc = RSTD[row] * (1.0f / W8_SCALE);
            u32x2 o; o.x = pk2(s[0] * sc, s[1] * sc); o.y = pk2(s[2] * sc, s[3] * sc); *(u32x2*)(Z + (size_t)row * LDZO + ZO_KR + col) = o; }
        __syncthreads();
    }
}

constexpr int NSTEPS = 1 + 2 * 6 + 2 * 8 - 1;
__global__ void __launch_bounds__(NT, 2) mk_fwd(Args A) {
    extern __shared__ __attribute__((aligned(16))) unsigned char lds_raw[];
    Frame F;
    F.lds = (LAS unsigned char*)lds_raw;
    F.tid = threadIdx.x; F.lane = F.tid & 63; F.wave = __builtin_amdgcn_readfirstlane(F.tid >> 6); F.w0 = F.wave; F.G = gridDim.x; F.c = blockIdx.x; F.ws = A.ws;
    volatile LAS unsigned* MISC = (volatile LAS unsigned*)(F.lds + MISC_OFF);
    if (F.tid < 64) MISC[F.tid] = 0u;
    __syncthreads();
    unsigned* ctl = (unsigned*)(A.ws + WS_CTL);
    XcdBarrier bar; bar.bar = ctl + CW_BAR; bar.x = 0; bar.st = MISC + 8;
    if (A.hi - A.lo > 1) bar = xcd_barrier_post(ctl + CW_BAR, MISC + 8);
    bar.w0 = F.w0;
    const float* x_in = (const float*)A.in[0];
    float* out = A.out;
    int step = 0;
#ifndef PHM
#define PHM 0xFFFFFF
#endif
#ifndef DBL
#define DBL 0
#endif
#define PHS(k, ...) { if constexpr (((PHM) >> (k)) & 1) { __VA_ARGS__ } if constexpr (((DBL) >> (k)) & 1) { __syncthreads(); __VA_ARGS__ } }
#define RUN(...) do { if (step >= A.lo && step < A.hi) { __VA_ARGS__ } if (step >= A.lo && step + 1 < A.hi) xcd_barrier_t<false>(bar); ++step; } while (0)
#define RUN_FIRST(...) do { if (step >= A.lo && step < A.hi) { __VA_ARGS__ } if (step >= A.lo && step + 1 < A.hi) xcd_barrier_t<true>(bar); ++step; } while (0)

    RUN_FIRST( PHS(0, prologue_phase(F, A);)
               PHS(1, rmsnorm_phase(F, x_in, (const float*)nullptr, (float*)(A.ws + WS_RSTD), (bf16*)(A.ws + WS_H), A.ws + WS_H8);) );
#pragma unroll 1
    for (int layer = 0; layer < DEPTH; ++layer) {
        const int j = layer >> 1; const bool odd = (layer & 1) != 0;
        size_t wz = 0; asm volatile("" : "+s"(wz)); unsigned char* ws = A.ws + wz;
        bf16* H = (bf16*)(ws + WS_H); unsigned char* H8 = ws + WS_H8; unsigned char* X18 = ws + WS_X18; float* PS = (float*)(ws + WS_PS); float* RSTD = (float*)(ws + WS_RSTD); bf16* XB = (bf16*)(ws + WS_XB); bf16* Z = (bf16*)(ws + WS_Z); unsigned char* MIX = ws + WS_MIX;     bf16* PE = (bf16*)(ws + WS_PE);
        if (layer > 0) RUN( PHS(1, rmsnorm_phase(F, (const float*)nullptr, PS, RSTD, H, H8);) );
        RUN( PHS(2, { const int N = odd ? ZO_KR : ZE_N8, ldz = odd ? LDZO : LDZE; const unsigned char* W = odd ? (ws + WS_WINO + (size_t)j * 41 * MiB) : (ws + WS_WINE8 + (size_t)j * 48 * MiB);
               pg8::Gemm gm{H8, W, MROWS, N, DM, DM}; pg8::SkewOrder S; S.init2(MROWS, N, F.G, F.c); if (odd) S.nfull = -1; pg8::EpiBf16 E{Z, ldz, 1.0f / W8_SCALE, RSTD};
               pg8::gemm_phase<pg8::EpiBf16, pg8::SkewOrder, true, true, true>(F.lds, gm, S, E, F.w0); })
             if (odd) PHS(2, kr_phase(F, H8, ws + WS_WINO + (size_t)j * 41 * MiB + (size_t)ZO_KR * DM, RSTD, Z);)
             if (!odd) PHS(2, { pg8::Gemm gm{layer == 0 ? H : XB, ws + WS_WINE16 + (size_t)j * 20 * MiB, MROWS, ZE_N16, DM * 2, DM * 2};     pg8::StaticOrder S; S.init(MROWS, ZE_N16, F.G, F.c); pg8::EpiBf16 E{Z + ZE_N8, LDZE, 1.0f, RSTD};
               pg8::gemm_phase<pg8::EpiBf16, pg8::StaticOrder, true, true>(F.lds, gm, S, E, F.w0); }) );
        if (!odd) {
            RUN( PHS(3, prep_even_phase(F, Z, (const float*)A.in[6] + j * 128);)
                 PHS(4, indexer_phase(F, Z, (unsigned*)(ws + WS_MASK), (float*)(ws + WS_SCR));)
                 PHS(5, retention_chunk_phase(F, Z, (bf16*)(ws + WS_RAW));) );
            RUN( PHS(16, ret_finish_phase(F, (const bf16*)(ws + WS_RAW), Z, (const float*)A.in[7] + j * 2048, MIX);)
                 PHS(6, { AttnP P{Z + ZE_QA, LDZE, Z + ZE_KA, LDZE, Z + ZE_VA, LDZE, Z + ZE_GA, LDZE, MIX, (const int*)A.in[2], (const unsigned*)(ws + WS_MASK), (const float*)A.in[5] + j * 128, (const float*)A.in[6] + j * 128}; attn_phase<0>(F, P); }) );
        } else {
            unsigned char* CQN = ws + WS_CQN; unsigned char* CKVN = ws + WS_CKVN;     bf16* QF = (bf16*)(ws + WS_QF); bf16* KVF = (bf16*)(ws + WS_KVF); bf16* KM = (bf16*)(ws + WS_KM);
            RUN( PHS(7, prep_odd1_phase(F, Z, (const float*)A.in[13] + j * 1536, (const float*)A.in[14] + j * 512, CQN, CKVN, (float*)(ws + WS_STATS));) );
            RUN( PHS(8, { pg8::Gemm gm{CQN, ws + WS_WUQ + (size_t)j * 9 * MiB, MROWS, 3072, 1536, 1536}; pg8::StaticOrder S; S.init(MROWS, 3072, F.G, F.c); pg8::EpiBf16 E{QF, 3072, 1.0f / (W8_SCALE * A8_SCALE), nullptr};
                   pg8::gemm_phase<pg8::EpiBf16, pg8::StaticOrder, true, true, true>(F.lds, gm, S, E, F.w0); })
                 PHS(9, { pg8::Gemm gm{CKVN, ws + WS_WUKV + (size_t)j * 4 * MiB, MROWS, 4096, 512, 512}; pg8::StaticOrder S; S.init(MROWS, 4096, F.G, F.c); pg8::EpiBf16 E{KVF, 4096, 1.0f / (W8_SCALE * A8_SCALE), nullptr};
                   pg8::gemm_phase<pg8::EpiBf16, pg8::StaticOrder, true, true, true>(F.lds, gm, S, E, F.w0); }) );
            RUN( PHS(10, prep_odd2_phase(F, QF, KVF, Z, KM, (const int*)A.in[2], (const float*)A.in[17] + j * 192, (const float*)A.in[18] + j * 192);)
                 PHS(11, gmlp_phase(F, Z, (const float*)(ws + WS_STATS), (const bf16*)(ws + WS_CWS) + (size_t)j * 16 * 128 * 128, (const float*)A.in[12] + j * 2048, (const float*)A.in[10] + j * 2048, MIX);) );
            RUN( PHS(12, { AttnP P{QF, 3072, KM, 192, KVF + 128, 4096, Z + ZO_GD, LDZO, MIX + 2048, (const int*)A.in[2], nullptr, (const float*)A.in[17] + j * 192, (const float*)A.in[18] + j * 192}; attn_phase<1>(F, P); }) );
        }
        RUN( PHS(13, { pg8::Gemm gm{MIX, ws + WS_WOUT + (size_t)layer * 16 * MiB, MROWS, DM, DM, DM}; pg8::StaticOrder S; S.init(MROWS, DM, F.G, F.c);
               pg8::EpiResid E{layer == 0 ? H : XB, XB, X18, DM, 1.0f / (W8_SCALE * MIX8_SCALE)};
               pg8::gemm_phase<pg8::EpiResid, pg8::StaticOrder, true, true, true>(F.lds, gm, S, E, F.w0); })
             PHS(14, { int kple = PLE; asm volatile("" : "+s"(kple)); pg8::Gemm gm{ws + WS_PB + (size_t)layer * MROWS * PLE, ws + WS_WPLE + (size_t)layer * 2 * MiB, MROWS, DM, kple, kple}; pg8::StaticOrder S; S.init(MROWS, DM, F.G, F.c);
               pg8::EpiBf16 E{PE, DM, 1.0f / (W8_SCALE * A8_SCALE), nullptr};
               pg8::gemm_phase<pg8::EpiBf16, pg8::StaticOrder, true, true, true>(F.lds, gm, S, E, F.w0); }) );
        RUN( PHS(15, { pg8::Gemm gm{X18, ws + WS_WGATE + (size_t)layer * 16 * MiB, MROWS, DM, DM, DM};   pg8::StaticOrder S; S.init(MROWS, DM, F.G, F.c);
               pg8::EpiGate E{XB, PE, layer == DEPTH - 1 ? out : (float*)nullptr, H8, PS, DM, 1.0f / W8_SCALE};
               pg8::gemm_phase<pg8::EpiGate, pg8::StaticOrder, true, true, true>(F.lds, gm, S, E, F.w0); }) );
    }
#undef RUN
#undef RUN_FIRST
}

extern "C" void kernel_launch(void* const* d_in, const int* in_sizes, int n_in, void* d_out, int out_size, void* d_ws, size_t ws_size, hipStream_t stream) {
    static int grid = 0;
    if (grid == 0) {
        if (n_in != 22 || in_sizes[0] != MROWS * DM || out_size != MROWS * DM || ws_size < WS_END) {
            fprintf(stderr, "kernel_launch: unexpected problem (n_in %d, in0 %d, out %d, ws %zu < %zu); nothing launched\n", n_in, n_in > 0 ? in_sizes[0] : -1, out_size, ws_size, (size_t)WS_END); grid = -1; return; }
        int dev = 0, cus = 0, per_cu = 0;
        if (hipGetDevice(&dev) != hipSuccess || hipDeviceGetAttribute(&cus, hipDeviceAttributeMultiprocessorCount, dev) != hipSuccess) { grid = -1; return; }
        if (hipFuncSetAttribute((const void*)mk_fwd, hipFuncAttributeMaxDynamicSharedMemorySize, LDS_BYTES) != hipSuccess) { fprintf(stderr, "kernel_launch: hipFuncSetAttribute failed\n"); grid = -1; return; }
        if (hipOccupancyMaxActiveBlocksPerMultiprocessor(&per_cu, (const void*)mk_fwd, NT, LDS_BYTES) != hipSuccess || per_cu < 1) fprintf(stderr, "kernel_launch: occupancy query says %d blocks per CU\n", per_cu);
        (void)hipGetLastError();
        grid = cus < 256 ? cus : 256;
    }
    if (grid < 0) return;
    if (hipMemsetAsync((char*)d_ws + WS_CTL, 0, CTL_ZERO_BYTES, stream) != hipSuccess) return;
    Args a{};
    for (int i = 0; i < 22; ++i) a.in[i] = d_in[i];
    a.out = (float*)d_out; a.ws = (unsigned char*)d_ws;
#if MK_MULTI
    for (int s = 0; s < NSTEPS; ++s) { a.lo = s; a.hi = s + 1; hipLaunchKernelGGL(mk_fwd, dim3(grid), dim3(NT), LDS_BYTES, stream, a); }
#else
    a.lo = 0; a.hi = NSTEPS; hipLaunchKernelGGL(mk_fwd, dim3(grid), dim3(NT), LDS_BYTES, stream, a);
#endif
    const hipError_t le = hipPeekAtLastError();
    if (le != hipSuccess) fprintf(stderr, "kernel_launch: launch failed: %s\n", hipGetErrorName(le));
}
```

```cpp
#include <hip/hip_runtime.h>
#include <cstdio>
#include <cstdint>

#ifndef MK_MULTI
#define MK_MULTI 0
#endif

namespace pg8 {
#define PG8_LAS __attribute__((address_space(3)))
__device__ __forceinline__ int hw_lane() { unsigned z = 0u; asm volatile("" : "+v"(z));     return (int)__builtin_amdgcn_mbcnt_hi(~0u, __builtin_amdgcn_mbcnt_lo(~0u, z)); }
typedef unsigned short bf16_t;
typedef short bf16x8 __attribute__((ext_vector_type(8)));
typedef float f32x4 __attribute__((ext_vector_type(4)));
typedef float f32x2 __attribute__((ext_vector_type(2)));
typedef unsigned u32x4 __attribute__((ext_vector_type(4)));
typedef unsigned u32x2 __attribute__((ext_vector_type(2)));
typedef __bf16 nbf16x2 __attribute__((ext_vector_type(2)));
constexpr int BM = 256, BK = 64, HALF = 128, HTB = HALF * BK * 2  , STAGE_BYTES = 8 * HTB, NXCD = 8, WGM = 8;

__host__ __device__ __forceinline__ int lds_byte(int r, int c) { const int st = (r >> 4) * 2 + (c >> 5), rr = r & 15, cc = c & 31, ob = rr * 64 + cc * 2; return st * 1024 + (ob ^ (((ob >> 9) & 1) << 5)); }
__host__ __device__ __forceinline__ void stage_rc(int b, int& R, int& C) { const int st = b / 1024, sb = b % 1024, swz = sb ^ (((sb >> 9) & 1) << 5); R = (st >> 1) * 16 + swz / 64; C = (st & 1) * 32 + (swz % 64) / 2; }
__host__ __device__ __forceinline__ int perm32(int rho) { const int n = rho >> 4, i = rho & 15; return 8 * (i >> 2) + 4 * n + (i & 3); }

struct Unit { int pm, pn; };
struct Gemm { const void* A; const void* Bt; int M, N, Kb, ldab; };
typedef int i32x8 __attribute__((ext_vector_type(8)));
typedef int i32x4 __attribute__((ext_vector_type(4)));
__device__ __forceinline__ i32x8 cat_f8(bf16x8 lo, bf16x8 hi) { const i32x4 a = __builtin_bit_cast(i32x4, lo), b = __builtin_bit_cast(i32x4, hi); return __builtin_shufflevector(a, b, 0, 1, 2, 3, 4, 5, 6, 7); }

struct StaticOrder {
    int nM, nN, nwg, G, c;
    __host__ __device__ void init(int M, int N, int G_, int c_) { nM = M / BM; nN = N / BM; nwg = nM * nN; G = G_; c = c_; }
    __host__ __device__ bool next(int i, Unit& u) const {
        const long L = (long)i * G + c; if (L >= nwg) return false;
        int wgid = (int)L; { const int q = nwg / NXCD, r = nwg % NXCD, xcd = wgid % NXCD, off = wgid / NXCD; wgid = (xcd < r ? xcd * (q + 1) : r * (q + 1) + (xcd - r) * q) + off; }
        const int nig = WGM * nN, gid = wgid / nig, fm = gid * WGM, gsz = (nM - fm) < WGM ? (nM - fm) : WGM;
        u.pm = fm + ((wgid % nig) % gsz); u.pn = (wgid % nig) / gsz; return true;
    }
    __device__ __forceinline__ void a_ready(const Unit&) const {}
    __device__ __forceinline__ void done(const Unit&) const {}
};

__device__ __forceinline__ unsigned cvt_pk_bf16(float lo, float hi) { const f32x2 v = {lo, hi}; const nbf16x2 b = __builtin_convertvector(v, nbf16x2); return __builtin_bit_cast(unsigned, b); }
__device__ __forceinline__ float clamp_f8(float x) { return __builtin_amdgcn_fmed3f(x, -448.0f, 448.0f); }
__device__ __forceinline__ unsigned cvt_pk4_fp8(float a, float b, float c, float d) { a = clamp_f8(a); b = clamp_f8(b); c = clamp_f8(c); d = clamp_f8(d); int w = 0; w = __builtin_amdgcn_cvt_pk_fp8_f32(a, b, w, false); w = __builtin_amdgcn_cvt_pk_fp8_f32(c, d, w, true); return (unsigned)w; }
__device__ __forceinline__ float fast_sigmoid(float a) { return __builtin_amdgcn_rcpf(1.0f + __builtin_amdgcn_exp2f(-1.4426950408889634f * a)); }

__device__ __forceinline__ float xsum16g(float v) { unsigned a = __float_as_uint(v), b = a; asm volatile("" : "+v"(b)); const u32x2 r = __builtin_amdgcn_permlane16_swap(a, b, false, false); return __uint_as_float(r.x) + __uint_as_float(r.y); }
__device__ __forceinline__ float xsum32g(float v) { unsigned a = __float_as_uint(v), b = a; asm volatile("" : "+v"(b)); const u32x2 r = __builtin_amdgcn_permlane32_swap(a, b, false, false); return __uint_as_float(r.x) + __uint_as_float(r.y); }
struct SkewOrder : StaticOrder {
    int nfull;
    __host__ __device__ void init2(int M, int N, int G_, int c_) { init(M, N, G_, c_); nfull = (nwg / G_) - 1; if (nfull < 0 || (nwg % G_) != 0 || (G_ & 1)) nfull = -1; }
    __host__ __device__ bool next(int i, Unit& u) const {
        if (nfull < 0) return StaticOrder::next(i, u);
        long L;
        if (i < nfull) L = (long)i * G + c;
        else { const int k = i - nfull; if (c < G / 2 || k >= 2) return false; L = (long)nfull * G + (long)(c - G / 2) * 2 + k; }
        if (L >= nwg) return false;
        int wgid = (int)L; { const int q = nwg / NXCD, r = nwg % NXCD, xcd = wgid % NXCD, off = wgid / NXCD; wgid = (xcd < r ? xcd * (q + 1) : r * (q + 1) + (xcd - r) * q) + off; }
        const int nig = WGM * nN, gid = wgid / nig, fm = gid * WGM, gsz = (nM - fm) < WGM ? (nM - fm) : WGM;
        u.pm = fm + ((wgid % nig) % gsz); u.pn = (wgid % nig) / gsz; return true;
    }
};
struct EpiBf16 {
    static constexpr bool PERM = true, AFTER_DRAIN = false;
    bf16_t* O; int ldc; float sc; const float* rs;
    __device__ __forceinline__ void operator()(const f32x4 (&acc)[2][2][4][2], const Unit& u, int wr, int wc, int fr_in, int fq) const {
        int fr = fr_in; asm volatile("" : "+v"(fr));
        const int row0 = u.pm * BM + wr * 64 + fr; const int col0 = u.pn * BM + wc * 32 + 8 * fq;
        float s2a[2][4];
        if (rs) { float r[8];
#pragma unroll
            for (int i = 0; i < 8; ++i) r[i] = rs[row0 + (i >> 2) * HALF + (i & 3) * 16];
            asm volatile("" : "+v"(r[0]), "+v"(r[1]), "+v"(r[2]), "+v"(r[3]), "+v"(r[4]), "+v"(r[5]), "+v"(r[6]), "+v"(r[7]));
#pragma unroll
            for (int i = 0; i < 8; ++i) s2a[i >> 2][i & 3] = sc * r[i]; }
        else {
#pragma unroll
            for (int i = 0; i < 8; ++i) s2a[i >> 2][i & 3] = sc; }
#pragma unroll
        for (int ai = 0; ai < 2; ++ai)
#pragma unroll
            for (int m = 0; m < 4; ++m) { bf16_t* rowp = O + (size_t)(row0 + ai * HALF + m * 16) * ldc + col0; const float s2 = s2a[ai][m];
#pragma unroll
                for (int bj = 0; bj < 2; ++bj) { const f32x4 v0 = acc[ai][bj][m][0] * s2, v1 = acc[ai][bj][m][1] * s2;
                    u32x4 w; w.x = cvt_pk_bf16(v0[0], v0[1]); w.y = cvt_pk_bf16(v0[2], v0[3]); w.z = cvt_pk_bf16(v1[0], v1[1]); w.w = cvt_pk_bf16(v1[2], v1[3]);
                    *(u32x4*)(rowp + bj * HALF) = w; } }
    }
};
__device__ __forceinline__ void unpack8(const u32x4 w, float (&v)[8]) {
#pragma unroll
    for (int e = 0; e < 4; ++e) { v[2 * e] = __uint_as_float(w[e] << 16); v[2 * e + 1] = __uint_as_float(w[e] & 0xffff0000u); } }
#define PG8_EOFF(g) ((size_t)(row0 + ((g) >> 2) * HALF + ((g) & 3) * 16) * ldc + col0)
struct EpiResid {
    static constexpr bool PERM = true, AFTER_DRAIN = false;
    const bf16_t* xin; bf16_t* xh; unsigned char* x8; int ldc; float sc;
    __device__ __forceinline__ void operator()(const f32x4 (&acc)[2][2][4][2], const Unit& u, int wr, int wc, int fr_in, int fq) const {
        int fr = fr_in; asm volatile("" : "+v"(fr));
        const int row0 = u.pm * BM + wr * 64 + fr, col0 = u.pn * BM + wc * 32 + 8 * fq;
        constexpr int D = 8; u32x4 buf[D][2];
#pragma unroll
        for (int g = 0; g < D; ++g)
#pragma unroll
            for (int bj = 0; bj < 2; ++bj) buf[g][bj] = *(const u32x4*)(xin + PG8_EOFF(g) + bj * HALF);
#pragma unroll
        for (int g = 0; g < 8; ++g) { const int ai = g >> 2, m = g & 3; const size_t off = PG8_EOFF(g);
#pragma unroll
            for (int bj = 0; bj < 2; ++bj) { const size_t o2 = off + bj * HALF; float bs[8], o[8]; unpack8(buf[g % D][bj], bs);
#pragma unroll
                for (int e = 0; e < 4; ++e) { o[e] = bs[e] + acc[ai][bj][m][0][e] * sc; o[4 + e] = bs[4 + e] + acc[ai][bj][m][1][e] * sc; }
                u32x4 w; w.x = cvt_pk_bf16(o[0], o[1]); w.y = cvt_pk_bf16(o[2], o[3]); w.z = cvt_pk_bf16(o[4], o[5]); w.w = cvt_pk_bf16(o[6], o[7]); *(u32x4*)(xh + o2) = w;
                u32x2 w8; w8.x = cvt_pk4_fp8(o[0], o[1], o[2], o[3]); w8.y = cvt_pk4_fp8(o[4], o[5], o[6], o[7]); *(u32x2*)(x8 + o2) = w8; }
            if (g + D < 8) {
#pragma unroll
                for (int bj = 0; bj < 2; ++bj) buf[g % D][bj] = *(const u32x4*)(xin + PG8_EOFF(g + D) + bj * HALF); }
            asm volatile("" ::: "memory"); }
    }
};
struct EpiGate {
    static constexpr bool PERM = true, AFTER_DRAIN = false;
    bf16_t* xh; const bf16_t* pe; float* out32; unsigned char* x8; float* ps; int ldc; float sc;
    __device__ __forceinline__ void operator()(const f32x4 (&acc)[2][2][4][2], const Unit& u, int wr, int wc, int fr_in, int fq) const {
        int fr = fr_in; asm volatile("" : "+v"(fr));
        const int row0 = u.pm * BM + wr * 64 + fr, col0 = u.pn * BM + wc * 32 + 8 * fq;
        const float sg = -1.4426950408889634f * sc;
        constexpr int D = 4; u32x4 bx[D][2], bp[D][2];
#pragma unroll
        for (int g = 0; g < D; ++g)
#pragma unroll
            for (int bj = 0; bj < 2; ++bj) { bx[g][bj] = *(const u32x4*)(xh + PG8_EOFF(g) + bj * HALF); bp[g][bj] = *(const u32x4*)(pe + PG8_EOFF(g) + bj * HALF); }
#pragma unroll
        for (int g = 0; g < 8; ++g) { const int ai = g >> 2, m = g & 3; const size_t off = PG8_EOFF(g); float ssq = 0.f;
#pragma unroll
            for (int bj = 0; bj < 2; ++bj) { const size_t o2 = off + bj * HALF; float xv[8], pv[8], o[8];
                unpack8(bx[g % D][bj], xv); unpack8(bp[g % D][bj], pv);
#pragma unroll
                for (int e = 0; e < 4; ++e) { o[e] = xv[e] + pv[e] * __builtin_amdgcn_rcpf(1.0f + __builtin_amdgcn_exp2f(acc[ai][bj][m][0][e] * sg)); o[4 + e] = xv[4 + e] + pv[4 + e] * __builtin_amdgcn_rcpf(1.0f + __builtin_amdgcn_exp2f(acc[ai][bj][m][1][e] * sg)); }
                if (out32) { *(f32x4*)(out32 + o2) = (f32x4){o[0], o[1], o[2], o[3]}; *(f32x4*)(out32 + o2 + 4) = (f32x4){o[4], o[5], o[6], o[7]}; }
                else { u32x4 w; w.x = cvt_pk_bf16(o[0], o[1]); w.y = cvt_pk_bf16(o[2], o[3]); w.z = cvt_pk_bf16(o[4], o[5]); w.w = cvt_pk_bf16(o[6], o[7]); *(u32x4*)(xh + o2) = w;
                       u32x2 w8; w8.x = cvt_pk4_fp8(o[0], o[1], o[2], o[3]); w8.y = cvt_pk4_fp8(o[4], o[5], o[6], o[7]); *(u32x2*)(x8 + o2) = w8;
#pragma unroll
                       for (int e = 0; e < 8; ++e) ssq += o[e] * o[e]; } }
            if (!out32) { ssq = xsum32g(xsum16g(ssq)); if (fq == 0) ps[(size_t)(row0 + ai * HALF + m * 16) * 64 + u.pn * 4 + wc] = ssq; }
            if (g + D < 8) {
#pragma unroll
                for (int bj = 0; bj < 2; ++bj) { bx[g % D][bj] = *(const u32x4*)(xh + PG8_EOFF(g + D) + bj * HALF); bp[g % D][bj] = *(const u32x4*)(pe + PG8_EOFF(g + D) + bj * HALF); } }
            asm volatile("" ::: "memory"); }
    }
};
#undef PG8_EOFF

template <class Epi, class Sched, bool ALIGN_EPI = false, bool SP2 = false, bool F8 = false>
__device__ __forceinline__ void gemm_phase(PG8_LAS unsigned char* lds, const Gemm g, const Sched S, const Epi E, const int w0) {
    int tid_ = (w0 << 6) | hw_lane(); asm volatile("" : "+v"(tid_));
    const int tid = tid_, wid = __builtin_amdgcn_readfirstlane(tid >> 6), lane = tid & 63, wr = wid >> 2, wc = wid & 3, fr = lane & 15, fq = lane >> 4;
    const int Kb = g.Kb, nt = Kb / (2 * BK), ldab = g.ldab;
    unsigned voffA[2], voffB[2];
#pragma unroll
    for (int i = 0; i < 2; ++i) { int R, C; stage_rc(tid * 16 + i * 8192, R, C); const int Rb = Epi::PERM ? ((R & ~31) + perm32(R & 31)) : R;
        voffA[i] = (unsigned)(R * ldab + C * 2); voffB[i] = (unsigned)(Rb * Kb + C * 2); }
    const size_t kstep = (size_t)(BK * 2);
    const size_t hstep = (size_t)HALF * Kb;
    const size_t tstep = 2 * hstep; const size_t hstepA = (size_t)HALF * ldab, tstepA = 2 * hstepA;
    const unsigned ldsw = (unsigned)wid * 1024u;
    const int aoff = lds_byte(wr * 64 + fr, fq * 8), boff = lds_byte(wc * 32 + fr, fq * 8);
#define PG8_SA(b, h) (((b) * 2 + (h)) * HTB)
#define PG8_SB(b, h) ((4 + (b) * 2 + (h)) * HTB)
#define PG8_STAGE(bufoff, gbase, voff) do { _Pragma("unroll") for (int _i = 0; _i < 2; ++_i) \
        __builtin_amdgcn_global_load_lds((const unsigned*)((const char*)(gbase) + (voff)[_i]), (PG8_LAS unsigned*)(lds + (bufoff) + ldsw + _i * 8192), 16, 0, 0); } while (0)
#define PG8_LDA(dst, b, h) do { _Pragma("unroll") for (int m = 0; m < 4; ++m) { if constexpr (F8) dst##8[m] = cat_f8(*(const PG8_LAS bf16x8*)(lds + PG8_SA(b, h) + aoff + m * 2048), *(const PG8_LAS bf16x8*)(lds + PG8_SA(b, h) + aoff + m * 2048 + 1024)); \
        else { _Pragma("unroll") for (int k = 0; k < 2; ++k) dst[m][k] = *(const PG8_LAS bf16x8*)(lds + PG8_SA(b, h) + aoff + m * 2048 + k * 1024); } } } while (0)
#define PG8_LDB(dst, b, h) do { _Pragma("unroll") for (int n = 0; n < 2; ++n) { if constexpr (F8) dst##8[n] = cat_f8(*(const PG8_LAS bf16x8*)(lds + PG8_SB(b, h) + boff + n * 2048), *(const PG8_LAS bf16x8*)(lds + PG8_SB(b, h) + boff + n * 2048 + 1024)); \
        else { _Pragma("unroll") for (int k = 0; k < 2; ++k) dst[n][k] = *(const PG8_LAS bf16x8*)(lds + PG8_SB(b, h) + boff + n * 2048 + k * 1024); } } } while (0)
#define PG8_MMA(ai, bj, At, Bt) do { __builtin_amdgcn_s_setprio(1); _Pragma("unroll") for (int m = 0; m < 4; ++m) _Pragma("unroll") for (int n = 0; n < 2; ++n) { \
        if constexpr (F8) asm volatile("v_mfma_f32_16x16x128_f8f6f4 %0, %1, %2, %0" : "+v"(acc[ai][bj][m][n]) : "v"(Bt##8[n]), "v"(At##8[m]));   \
        else { _Pragma("unroll") for (int k = 0; k < 2; ++k) acc[ai][bj][m][n] = __builtin_amdgcn_mfma_f32_16x16x32_bf16(Bt[n][k], At[m][k], acc[ai][bj][m][n], 0, 0, 0); } } \
        __builtin_amdgcn_s_setprio(0); } while (0)
#define PG8_WAIT_V(n) asm volatile("s_waitcnt vmcnt(" #n ")" ::: "memory")
#define PG8_WAIT_L(n) asm volatile("s_waitcnt lgkmcnt(" #n ")" ::: "memory")
#define PG8_BAR __builtin_amdgcn_s_barrier()
#define PG8_SCHED __builtin_amdgcn_sched_barrier(0)
    Unit cur, nxt; int ui = 0;
    if (!S.next(0, cur)) return;
    f32x4 acc[2][2][4][2];
#pragma unroll
    for (int a = 0; a < 2; ++a)
#pragma unroll
        for (int b = 0; b < 2; ++b)
#pragma unroll
            for (int m = 0; m < 4; ++m)
#pragma unroll
                for (int n = 0; n < 2; ++n) acc[a][b][m][n] = (f32x4){0.f, 0.f, 0.f, 0.f};
    bf16x8 At[4][2], B0[2][2], B1[2][2]; i32x8 At8[4], B08[2], B18[2];
    const char* cA = (const char*)g.A + (size_t)cur.pm * tstepA; const char* cB = (const char*)g.Bt + (size_t)cur.pn * tstep;
    S.a_ready(cur);
    if constexpr (SP2) {
        PG8_STAGE(PG8_SB(0, 0), cB, voffB); PG8_STAGE(PG8_SB(0, 1), cB + hstep, voffB); PG8_STAGE(PG8_SA(0, 0), cA, voffA); PG8_STAGE(PG8_SA(0, 1), cA + hstepA, voffA);
        if (wr == 1) PG8_BAR;
        PG8_WAIT_V(2); PG8_BAR;
        PG8_STAGE(PG8_SB(1, 0), cB + kstep, voffB); PG8_STAGE(PG8_SA(1, 0), cA + kstep, voffA); PG8_STAGE(PG8_SB(1, 1), cB + hstep + kstep, voffB);
        PG8_WAIT_V(6); PG8_BAR;
    } else {
        PG8_STAGE(PG8_SB(0, 0), cB, voffB); PG8_STAGE(PG8_SA(0, 0), cA, voffA); PG8_STAGE(PG8_SB(0, 1), cB + hstep, voffB); PG8_STAGE(PG8_SA(0, 1), cA + hstepA, voffA);
        if (wr == 1) PG8_BAR;
        PG8_WAIT_V(4); PG8_BAR;
        PG8_STAGE(PG8_SB(1, 0), cB + kstep, voffB); PG8_STAGE(PG8_SA(1, 0), cA + kstep, voffA); PG8_STAGE(PG8_SB(1, 1), cB + hstep + kstep, voffB);
        PG8_WAIT_V(6); PG8_BAR;
    }
    for (;;) {
        const bool has_next = S.next(ui + 1, nxt);
        const char* nA = has_next ? (const char*)g.A + (size_t)nxt.pm * tstepA : cA; const char* nB = has_next ? (const char*)g.Bt + (size_t)nxt.pn * tstep : cB;
        for (int t = 0; t < nt; t += 2) {
            const bool last = (t == nt - 2);
            const char* a1 = cA + (size_t)(t + 1) * kstep;
            const char* a2 = last ? nA : cA + (size_t)(t + 2) * kstep; const char* b2 = last ? nB : cB + (size_t)(t + 2) * kstep;
            const char* a3 = a2 + kstep; const char* b3 = b2 + kstep;
            if (last && has_next) S.a_ready(nxt);
            if constexpr (SP2) {
            PG8_LDB(B0, 0, 0); PG8_LDB(B1, 0, 1); PG8_SCHED; PG8_LDA(At, 0, 0); PG8_STAGE(PG8_SA(1, 1), a1 + hstepA, voffA);
            PG8_WAIT_V(8); PG8_WAIT_L(0); PG8_BAR; PG8_MMA(0, 0, At, B0); PG8_MMA(0, 1, At, B1); PG8_BAR; PG8_SCHED;
            PG8_LDA(At, 0, 1); PG8_STAGE(PG8_SB(0, 0), b2, voffB); PG8_STAGE(PG8_SB(0, 1), b2 + hstep, voffB); PG8_STAGE(PG8_SA(0, 0), a2, voffA);
            PG8_WAIT_V(8); PG8_WAIT_L(0); PG8_BAR; PG8_MMA(1, 0, At, B0); PG8_MMA(1, 1, At, B1); PG8_BAR; PG8_SCHED;
            PG8_LDB(B0, 1, 0); PG8_LDB(B1, 1, 1); PG8_SCHED; PG8_LDA(At, 1, 0); PG8_STAGE(PG8_SA(0, 1), a2 + hstepA, voffA);
            PG8_WAIT_V(8); PG8_WAIT_L(0); PG8_BAR; PG8_MMA(0, 0, At, B0); PG8_MMA(0, 1, At, B1); PG8_BAR; PG8_SCHED;
            PG8_LDA(At, 1, 1); PG8_STAGE(PG8_SB(1, 0), b3, voffB); PG8_STAGE(PG8_SB(1, 1), b3 + hstep, voffB); PG8_STAGE(PG8_SA(1, 0), a3, voffA);
            PG8_WAIT_V(8); PG8_WAIT_L(0); PG8_BAR; PG8_MMA(1, 0, At, B0); PG8_MMA(1, 1, At, B1); PG8_BAR; PG8_SCHED;
            } else {
            PG8_LDB(B0, 0, 0); PG8_SCHED; PG8_LDA(At, 0, 0); PG8_STAGE(PG8_SA(1, 1), a1 + hstepA, voffA);
            PG8_WAIT_L(8); PG8_BAR; PG8_WAIT_L(0); PG8_MMA(0, 0, At, B0); PG8_BAR; PG8_SCHED;
            PG8_LDB(B1, 0, 1); PG8_STAGE(PG8_SB(0, 0), b2, voffB);
            PG8_BAR; PG8_WAIT_L(0); PG8_MMA(0, 1, At, B1); PG8_BAR;
            PG8_LDA(At, 0, 1); PG8_STAGE(PG8_SA(0, 0), a2, voffA);
            PG8_BAR; PG8_WAIT_L(0); PG8_MMA(1, 0, At, B0); PG8_BAR; PG8_SCHED;
            PG8_STAGE(PG8_SB(0, 1), b2 + hstep, voffB);
            PG8_WAIT_V(6); PG8_BAR; PG8_MMA(1, 1, At, B1); PG8_BAR;
            PG8_LDB(B0, 1, 0); PG8_SCHED; PG8_LDA(At, 1, 0); PG8_STAGE(PG8_SA(0, 1), a2 + hstepA, voffA);
            PG8_WAIT_L(8); PG8_BAR; PG8_WAIT_L(0); PG8_MMA(0, 0, At, B0); PG8_BAR; PG8_SCHED;
            PG8_LDB(B1, 1, 1); PG8_STAGE(PG8_SB(1, 0), b3, voffB);
            PG8_BAR; PG8_WAIT_L(0); PG8_MMA(0, 1, At, B1); PG8_BAR;
            PG8_LDA(At, 1, 1); PG8_STAGE(PG8_SA(1, 0), a3, voffA);
            PG8_BAR; PG8_WAIT_L(0); PG8_MMA(1, 0, At, B0); PG8_BAR; PG8_SCHED;
            PG8_STAGE(PG8_SB(1, 1), b3 + hstep, voffB);
            PG8_WAIT_V(6); PG8_BAR; PG8_MMA(1, 1, At, B1); PG8_BAR;
            }
        }
        if constexpr (F8) {
            asm volatile("s_nop 15\n\ts_nop 15" ::: "memory");
#pragma unroll
            for (int a_ = 0; a_ < 2; ++a_)
#pragma unroll
                for (int b_ = 0; b_ < 2; ++b_)
#pragma unroll
                    for (int m_ = 0; m_ < 4; ++m_) asm volatile("" : "+v"(acc[a_][b_][m_][0]), "+v"(acc[a_][b_][m_][1]));
        }
        if constexpr (ALIGN_EPI) { if (wr == 0) PG8_BAR; }
        if constexpr (!Epi::AFTER_DRAIN) { E(acc, cur, wr, wc, fr, fq); S.done(cur); }
        if (!has_next) break;
#pragma unroll
        for (int a = 0; a < 2; ++a)
#pragma unroll
            for (int b = 0; b < 2; ++b)
#pragma unroll
                for (int m = 0; m < 4; ++m)
#pragma unroll
                    for (int n = 0; n < 2; ++n) acc[a][b][m][n] = (f32x4){0.f, 0.f, 0.f, 0.f};
        cur = nxt; cA = nA; cB = nB; ++ui;
        if constexpr (ALIGN_EPI) { if (wr == 1) PG8_BAR; }
    }
    PG8_WAIT_V(0);
    if constexpr (!ALIGN_EPI) { if (wr == 0) PG8_BAR; }
    PG8_BAR;
    if constexpr (Epi::AFTER_DRAIN) { E.fused(acc, cur, wr, wc, fr, fq, lds, wid, lane); S.done(cur); }
#undef PG8_SA
#undef PG8_SB
#undef PG8_STAGE
#undef PG8_LDA
#undef PG8_LDB
#undef PG8_MMA
#undef PG8_WAIT_V
#undef PG8_WAIT_L
#undef PG8_BAR
#undef PG8_SCHED
}
}

constexpr int NWAVES = 8, NT = 512;
constexpr int BATCH = 8, SEQ = 2048, DM = 4096, MROWS = BATCH * SEQ, DEPTH = 4, PLE = 256;
constexpr int LDZE = 14848, LDZO = 10496;
constexpr int ZE_QA = 0, ZE_GA = 2048, ZE_QB = 4096, ZE_KB = 6144, ZE_VB = 8192, ZE_GB = 10240, ZE_KA = 12288, ZE_VA = 12416, ZE_IQ = 12544, ZE_IK = 14592, ZE_IW = 14720;
constexpr int ZE_N8 = 12288, ZE_N16 = 2560;
constexpr int ZO_CU = 0, ZO_CV = 2048, ZO_GC = 4096, ZO_GD = 6144, ZO_CQ = 8192, ZO_CKV = 9728, ZO_KR = 10240;
constexpr int EVEN_IN = 14736, ODD_IN = 10304;
constexpr float NORM_EPS = 1e-6f;
constexpr float MIX8_SCALE = 4.0f;
constexpr float A8_SCALE = 8.0f;
constexpr float W8_SCALE = 256.0f;

constexpr size_t MiB = 1u << 20;
constexpr size_t WS_CTL = 0, CTL_ZERO_BYTES = 1 * MiB;
constexpr size_t WS_SCR = 1 * MiB;
constexpr size_t WS_MASK = 33 * MiB;
constexpr size_t WS_STATS = 37 * MiB;
constexpr size_t WS_PB = 38 * MiB;
constexpr size_t WS_CWS = 70 * MiB;
constexpr size_t WS_WINE8 = 71 * MiB;
constexpr size_t WS_WINE16 = 167 * MiB;
constexpr size_t WS_WINO = 207 * MiB;
constexpr size_t WS_WOUT = 289 * MiB;
constexpr size_t WS_WGATE = 353 * MiB;
constexpr size_t WS_WPLE = 417 * MiB;
constexpr size_t WS_WUQ = 425 * MiB;
constexpr size_t WS_WUKV = 443 * MiB;
constexpr size_t WS_H = 451 * MiB;
constexpr size_t WS_H8 = 579 * MiB;
constexpr size_t WS_RAW = 643 * MiB;
constexpr size_t WS_XB = 707 * MiB;
constexpr size_t WS_PS = 835 * MiB;
constexpr size_t WS_RSTD = 840 * MiB;
constexpr size_t WS_X18 = 1413 * MiB;
constexpr size_t WS_Z = 885 * MiB;
constexpr size_t WS_PE = WS_Z;
constexpr size_t WS_CQN = WS_Z + 328 * MiB;
constexpr size_t WS_CKVN = WS_Z + 376 * MiB;
constexpr size_t WS_MIX = 1349 * MiB;
constexpr size_t WS_QF = 1477 * MiB;
constexpr size_t WS_KVF = 1573 * MiB;
constexpr size_t WS_KM = 1701 * MiB;
constexpr size_t WS_END = 1797 * MiB;
constexpr int CW_BAR = 4096;

constexpr int RING_BYTES = 131072;
constexpr int MISC_OFF = RING_BYTES;
constexpr int LDS_BYTES = 147456;

#define GAS __attribute__((address_space(1)))
#define LAS __attribute__((address_space(3)))
typedef unsigned short bf16;
typedef short bf16x8 __attribute__((ext_vector_type(8)));
typedef short s16x4 __attribute__((ext_vector_type(4)));
typedef float f32x4 __attribute__((ext_vector_type(4)));
typedef float f32x2 __attribute__((ext_vector_type(2)));
typedef unsigned u32x4 __attribute__((ext_vector_type(4)));
typedef unsigned u32x2 __attribute__((ext_vector_type(2)));
typedef int i32x4 __attribute__((ext_vector_type(4)));
#define LDS_WAIT() asm volatile("s_waitcnt lgkmcnt(0)" ::: "memory")
#define VM_WAIT() asm volatile("s_waitcnt vmcnt(0)" ::: "memory")
#define MFMA16(a, b, c) __builtin_amdgcn_mfma_f32_16x16x32_bf16((a), (b), (c), 0, 0, 0)
__device__ __forceinline__ unsigned pk2(float lo, float hi) { return pg8::cvt_pk_bf16(lo, hi); }
__device__ __forceinline__ float bflo(unsigned w) { return __uint_as_float(w << 16); }
__device__ __forceinline__ float bfhi(unsigned w) { return __uint_as_float(w & 0xffff0000u); }
__device__ __forceinline__ float fsig(float a) { return pg8::fast_sigmoid(a); }
__device__ __forceinline__ float fsilu(float a) { return a * fsig(a); }
__device__ __forceinline__ float fgelu(float x) { const float y = 0.7978845608028654f * (x + 0.044715f * x * x * x); return x * fsig(2.0f * y); }
__device__ __forceinline__ float shx(float v, int mask, int lane) { return __builtin_bit_cast(float, __builtin_amdgcn_ds_bpermute((lane ^ mask) << 2, __builtin_bit_cast(int, v))); }
__device__ __forceinline__ float xmax16(float v) { unsigned a = __float_as_uint(v), b = a; asm volatile("" : "+v"(b)); const u32x2 r = __builtin_amdgcn_permlane16_swap(a, b, false, false); return __builtin_amdgcn_fmed3f(__uint_as_float(r.x), __uint_as_float(r.y), __builtin_inff()); }
__device__ __forceinline__ float xmax32(float v) { unsigned a = __float_as_uint(v), b = a; asm volatile("" : "+v"(b)); const u32x2 r = __builtin_amdgcn_permlane32_swap(a, b, false, false); return __builtin_amdgcn_fmed3f(__uint_as_float(r.x), __uint_as_float(r.y), __builtin_inff()); }
__device__ __forceinline__ float xsum16(float v) { unsigned a = __float_as_uint(v), b = a; asm volatile("" : "+v"(b)); const u32x2 r = __builtin_amdgcn_permlane16_swap(a, b, false, false); return __uint_as_float(r.x) + __uint_as_float(r.y); }
__device__ __forceinline__ float xsum32(float v) { unsigned a = __float_as_uint(v), b = a; asm volatile("" : "+v"(b)); const u32x2 r = __builtin_amdgcn_permlane32_swap(a, b, false, false); return __uint_as_float(r.x) + __uint_as_float(r.y); }
__device__ __forceinline__ float wave_sum(float v, int lane) {
#pragma unroll
    for (int o = 1; o < 64; o <<= 1) v += shx(v, o, lane);
    return v;
}
__device__ __forceinline__ s16x4 tr_read(const LAS unsigned char* p) { return __builtin_amdgcn_ds_read_tr16_b64_v4i16((LAS s16x4*)p); }
__device__ __forceinline__ bf16x8 cat8(s16x4 a, s16x4 b) { bf16x8 r; r[0] = a[0]; r[1] = a[1]; r[2] = a[2]; r[3] = a[3]; r[4] = b[0]; r[5] = b[1]; r[6] = b[2]; r[7] = b[3]; return r; }

#define XB_TMO      128
#define XB_XCNT(j)  (256  + 64 * (j))
#define XB_XSUB(j)  (1280 + 64 * (j))
#define XB_XGEN(j)  (2304 + 64 * (j))
#define XB_TOP      3328
#define XB_TOPGEN   3392
#define XCD_BAR_WORDS 3456
#define XB_SPIN_CAP (1u << 20)
__device__ __forceinline__ unsigned xb_ld(unsigned* p)              { return __hip_atomic_load(p, __ATOMIC_RELAXED, __HIP_MEMORY_SCOPE_AGENT); }
__device__ __forceinline__ unsigned xb_add(unsigned* p, unsigned v) { return __hip_atomic_fetch_add(p, v, __ATOMIC_RELAXED, __HIP_MEMORY_SCOPE_AGENT); }
__device__ __forceinline__ unsigned xb_xcc_id() { return (unsigned)__builtin_amdgcn_s_getreg((3 << 11) | 20) & 0xFu; }
#define XB_SPIN(cond, bar) do { unsigned _sp = 0; while (cond) { __builtin_amdgcn_s_sleep(1); \
    if ((++_sp & 255u) == 0u) { if (xb_ld(&(bar)[XB_TMO])) break; if (_sp > XB_SPIN_CAP) { atomicAdd(&(bar)[XB_TMO], 1u); break; } } } } while (0)
struct XcdBarrier { unsigned* bar; unsigned x; volatile LAS unsigned* st; int w0; };
__device__ __forceinline__ XcdBarrier xcd_barrier_post(unsigned* bar, volatile LAS unsigned* st) {
    XcdBarrier b; b.bar = bar; b.x = xb_xcc_id(); b.st = st; b.w0 = 0;
    if (threadIdx.x == 0) (void)xb_add(&bar[XB_XCNT(b.x)], 1u);
    return b;
}
__device__ __forceinline__ void xcd_barrier_complete(unsigned* bar, unsigned x, unsigned& nloc, unsigned& nx) {
    const unsigned G = gridDim.x * gridDim.y * gridDim.z;
    unsigned sum, cnt, mine, sp = 0u;
    for (;;) {
        sum = 0u; cnt = 0u; mine = 0u;
#pragma unroll
        for (unsigned j = 0; j < 16; ++j) { const unsigned c = xb_ld(&bar[XB_XCNT(j)]); sum += c; cnt += (c > 0u) ? 1u : 0u; mine = (j == x) ? c : mine; }
        if (sum == G) break;
        __builtin_amdgcn_s_sleep(1);
        if ((++sp & 255u) == 0u) { if (xb_ld(&bar[XB_TMO])) break; if (sp > XB_SPIN_CAP) { atomicAdd(&bar[XB_TMO], 1u); break; } }
    }
    nloc = mine > 0u ? mine : 1u; nx = cnt > 0u ? cnt : 1u;
}
template <bool FIRST>
__device__ __forceinline__ void xcd_barrier_t(const XcdBarrier& b) {
    asm volatile("s_waitcnt vmcnt(0)" ::: "memory");
    __syncthreads();
    if (b.w0 == 0 && pg8::hw_lane() == 0) {
        unsigned* bar = b.bar; asm volatile("" : "+s"(bar));
        __builtin_amdgcn_s_waitcnt(0);
        unsigned nloc = b.st[0], nx = b.st[1];
        if constexpr (FIRST) { if (nloc == 0u) { xcd_barrier_complete(bar, b.x, nloc, nx); b.st[0] = nloc; b.st[1] = nx; } }
        else { nloc = nloc ? nloc : 1u; nx = nx ? nx : 1u; }
        const unsigned old = xb_add(&bar[XB_XSUB(b.x)], 1u);
        const unsigned gen = old / nloc;
        if (old + 1u == (gen + 1u) * nloc) {
            __builtin_amdgcn_fence(__ATOMIC_RELEASE, "agent");
            asm volatile("s_waitcnt vmcnt(0)" ::: "memory");
            const unsigned og = xb_add(&bar[XB_TOP], 1u);
            const unsigned tg = og / nx;
            if (og + 1u == (tg + 1u) * nx) xb_add(&bar[XB_TOPGEN], 1u);
            else XB_SPIN(xb_ld(&bar[XB_TOPGEN]) == tg, bar);
            __builtin_amdgcn_fence(__ATOMIC_ACQUIRE, "agent");
            xb_add(&bar[XB_XGEN(b.x)], 1u);
            asm volatile("s_waitcnt vmcnt(0)" ::: "memory");
        } else {
            XB_SPIN(xb_ld(&bar[XB_XGEN(b.x)]) == gen, bar);
            __builtin_amdgcn_fence(__ATOMIC_ACQUIRE, "agent");
            asm volatile("s_waitcnt vmcnt(0)" ::: "memory");
        }
    }
    __syncthreads();
}

struct Args { const void* in[22]; float* out; unsigned char* ws; int lo, hi; };
#define OPAQUE_TID() do { int t_ = (F.w0 << 6) | pg8::hw_lane(); asm volatile("" : "+v"(t_)); F.tid = t_; F.lane = t_ & 63; F.wave = __builtin_amdgcn_readfirstlane(t_ >> 6); int g_ = gridDim.x, c_ = blockIdx.x; asm volatile("" : "+s"(g_), "+s"(c_)); F.G = g_; F.c = c_; F.vc = (g_ % 8 == 0) ? (c_ % 8) * (g_ / 8) + c_ / 8 : c_; } while (0)
struct Frame {
    LAS unsigned char* lds;
    int tid, lane, wave, w0, G, c, vc;
    unsigned char* ws;
};

struct Task { int in_idx, src_off, K, Nsrc, c0, nvalid, ntot, dst_row0; unsigned dst_kb; int item0; int f8; float wsc; int gain_off; };
constexpr int NTASK = 42;
struct TaskTable { Task t[NTASK]; int total; };
constexpr TaskTable make_tasks() {
    TaskTable T{}; int n = 0;
    for (int j = 0; j < 2; ++j) {
        const int so = j * 4096 * EVEN_IN; const unsigned d8 = (unsigned)((WS_WINE8 + (size_t)j * 48 * MiB) >> 10), d16 = (unsigned)((WS_WINE16 + (size_t)j * 20 * MiB) >> 10);
        const int seg8[6][4] = {{0, 2048, 2048, ZE_QA}, {4496, 2048, 2048, ZE_GA}, {6544, 2048, 2048, ZE_QB}, {8592, 2048, 2048, ZE_KB}, {10640, 2048, 2048, ZE_VB}, {12688, 2048, 2048, ZE_GB}};
        const int seg16[3][4] = {{2048, 256, 256, ZE_KA - ZE_N8}, {2304, 2048, 2048, ZE_IQ - ZE_N8}, {4352, 144, 256, ZE_IK - ZE_N8}};
        for (int s = 0; s < 6; ++s) T.t[n++] = Task{4, so, 4096, EVEN_IN, seg8[s][0], seg8[s][1], seg8[s][2], seg8[s][3], d8, 0, 1, W8_SCALE, (2 * j) * 4096};
        for (int s = 0; s < 3; ++s) T.t[n++] = Task{4, so, 4096, EVEN_IN, seg16[s][0], seg16[s][1], seg16[s][2], seg16[s][3], d16, 0, 0, 1.0f, (2 * j) * 4096};
    }
    for (int j = 0; j < 2; ++j) {
        const int so = j * 4096 * ODD_IN; const unsigned d = (unsigned)((WS_WINO + (size_t)j * 41 * MiB) >> 10);
        const int seg[4][4] = {{0, 6144, 6144, ZO_CU}, {8256, 2048, 2048, ZO_GD}, {6144, 2048, 2048, ZO_CQ}, {8192, 64, 256, ZO_KR}};
        for (int s = 0; s < 4; ++s) T.t[n++] = Task{9, so, 4096, ODD_IN, seg[s][0], seg[s][1], seg[s][2], seg[s][3], d, 0, 1, W8_SCALE, (2 * j + 1) * 4096};
    }
    for (int i = 0; i < 4; ++i) T.t[n++] = Task{(i & 1) ? 19 : 8, (i >> 1) * 4096 * 4096, 4096, 4096, 0, 4096, 4096, 0, (unsigned)((WS_WOUT + (size_t)i * 16 * MiB) >> 10), 0, 1, W8_SCALE, -1};
    for (int i = 0; i < 4; ++i) T.t[n++] = Task{21, i * 4096 * 4096, 4096, 4096, 0, 4096, 4096, 0, (unsigned)((WS_WGATE + (size_t)i * 16 * MiB) >> 10), 0, 1, W8_SCALE, -1};
    for (int i = 0; i < 4; ++i) T.t[n++] = Task{20, i * 256 * 4096, 256, 4096, 0, 4096, 4096, 0, (unsigned)((WS_WPLE + (size_t)i * 2 * MiB) >> 10), 0, 1, W8_SCALE, -1};
    for (int j = 0; j < 2; ++j) T.t[n++] = Task{15, j * 1536 * 3072, 1536, 3072, 0, 3072, 3072, 0, (unsigned)((WS_WUQ + (size_t)j * 9 * MiB) >> 10), 0, 1, W8_SCALE, -1};
    for (int j = 0; j < 2; ++j) T.t[n++] = Task{16, j * 512 * 4096, 512, 4096, 0, 4096, 4096, 0, (unsigned)((WS_WUKV + (size_t)j * 4 * MiB) >> 10), 0, 1, W8_SCALE, -1};
    int acc = 0;
    for (int i = 0; i < NTASK; ++i) { T.t[i].item0 = acc; acc += (T.t[i].K / 64) * (T.t[i].ntot / 64); }
    T.total = acc;
    return T;
}
__constant__ TaskTable g_tasks = make_tasks();

struct ItemDesc { const float* src; bf16* dst; const float* gain; int K, Nsrc, f8; float wsc; bool ok; };
__device__ __forceinline__ ItemDesc item_desc(const Args& A, unsigned char* ws, int it_, int lane, int& ti_) {
    const int it = __builtin_amdgcn_readfirstlane(it_); int ti = __builtin_amdgcn_readfirstlane(ti_);
#pragma unroll 1
    while (ti + 1 < NTASK && it >= g_tasks.t[ti + 1].item0) ++ti;
    ti_ = ti;
    const Task tk = g_tasks.t[ti]; const int item = it - tk.item0;
    const int nblk = tk.ntot / 64, kb = item / nblk, nb = item - kb * nblk, k0 = 64 * kb, n0 = 64 * nb, rgrp = lane >> 4, c4 = lane & 15;
    ItemDesc d; d.K = tk.K; d.Nsrc = tk.Nsrc; d.f8 = tk.f8; d.wsc = tk.wsc; d.ok = (n0 + 4 * c4) < tk.nvalid;
    d.src = (const float*)A.in[tk.in_idx] + tk.src_off + (size_t)(k0 + rgrp) * tk.Nsrc + tk.c0 + n0 + 4 * c4;
    d.gain = tk.gain_off >= 0 ? (const float*)A.in[3] + tk.gain_off + k0 : (const float*)nullptr;
    d.dst = (bf16*)(ws + ((size_t)tk.dst_kb << 10));
    d.dst = (bf16*)((unsigned char*)d.dst + ((size_t)(tk.dst_row0 + n0) * tk.K + k0) * (tk.f8 ? 1 : 2));
    return d;
}
__device__ __forceinline__ void item_load(const ItemDesc& d, f32x4 (&v)[16], f32x4 (&gq)[2], int lane) {
    gq[0] = (f32x4){1.f, 1.f, 1.f, 1.f}; gq[1] = gq[0];
    if (d.gain) { const int c = lane & 7; gq[0] = *(const f32x4*)(d.gain + 8 * c); gq[1] = *(const f32x4*)(d.gain + 8 * c + 4); }
#pragma unroll
    for (int i = 0; i < 16; ++i) v[i] = d.ok ? *(const f32x4*)(d.src + (size_t)(4 * i) * d.Nsrc) : (f32x4){0.f, 0.f, 0.f, 0.f};
}
__device__ __forceinline__ void item_store(const ItemDesc& d, const f32x4 (&v)[16], const f32x4 (&gq)[2], LAS float* scr, int lane) {
    const int rgrp = lane >> 4, c4 = lane & 15;
#pragma unroll
    for (int i = 0; i < 16; ++i) { const int row = 4 * i + rgrp; *(LAS f32x4*)(scr + row * 64 + ((c4 ^ ((row >> 3) & 7)) << 2)) = v[i]; }
    LDS_WAIT(); asm volatile("" ::: "memory");
    const int c = lane & 7, nl = lane >> 3; const float wsc = d.wsc;
    float gk[8];
    { const f32x4 ga = gq[0], gb = gq[1];
#pragma unroll
      for (int e = 0; e < 4; ++e) { gk[e] = ga[e] * wsc; gk[4 + e] = gb[e] * wsc; } }
#pragma unroll
    for (int j = 0; j < 8; ++j) { const int n = nl + 8 * j; const LAS float* s = scr + (8 * c) * 64 + ((((n >> 2) ^ c) << 2) + (n & 3));
        if (d.f8) { u32x2 o; o.x = pg8::cvt_pk4_fp8(s[0 * 64] * gk[0], s[1 * 64] * gk[1], s[2 * 64] * gk[2], s[3 * 64] * gk[3]); o.y = pg8::cvt_pk4_fp8(s[4 * 64] * gk[4], s[5 * 64] * gk[5], s[6 * 64] * gk[6], s[7 * 64] * gk[7]);
            *(u32x2*)((unsigned char*)d.dst + (size_t)n * d.K + 8 * c) = o; }
        else { u32x4 o; o.x = pk2(s[0 * 64] * gk[0], s[1 * 64] * gk[1]); o.y = pk2(s[2 * 64] * gk[2], s[3 * 64] * gk[3]); o.z = pk2(s[4 * 64] * gk[4], s[5 * 64] * gk[5]); o.w = pk2(s[6 * 64] * gk[6], s[7 * 64] * gk[7]);
            *(u32x4*)(d.dst + (size_t)n * d.K + 8 * c) = o; } }
    LDS_WAIT(); asm volatile("" ::: "memory");
}
__device__ __forceinline__ void prologue_phase(Frame& F, const Args& A) {
    OPAQUE_TID();
    LAS float* scr = (LAS float*)(F.lds + F.wave * 16384);
    const int gw = F.c * NWAVES + F.wave, NGW = F.G * NWAVES;
    const int total = g_tasks.total;
    if (gw < total) {
        int ti = 0; ItemDesc cur = item_desc(A, F.ws, gw, F.lane, ti); f32x4 vc[16], vn[16], gc[2], gn2[2]; item_load(cur, vc, gc, F.lane);
        for (int it = gw; it < total; it += NGW) {
            const bool more = (it + NGW < total);
            ItemDesc nxt = cur; if (more) { nxt = item_desc(A, F.ws, it + NGW, F.lane, ti); item_load(nxt, vn, gn2, F.lane); }
            item_store(cur, vc, gc, scr, F.lane);
            cur = nxt;
#pragma unroll
            for (int i = 0; i < 16; ++i) vc[i] = vn[i];
            gc[0] = gn2[0]; gc[1] = gn2[1];
        }
    }
    { const f32x4* p4 = (const f32x4*)A.in[1]; unsigned* o = (unsigned*)(F.ws + WS_PB); const size_t n4 = (size_t)DEPTH * MROWS * PLE / 4;
      const size_t st = (size_t)F.G * NT;
      for (size_t i = (size_t)F.c * NT + F.tid; i < n4; i += 4 * st) { f32x4 v[4];
#pragma unroll
          for (int k = 0; k < 4; ++k) { const size_t j = i + k * st; v[k] = p4[j < n4 ? j : n4 - 1]; }
          asm volatile("" : "+v"(v[0]), "+v"(v[1]), "+v"(v[2]), "+v"(v[3]));
#pragma unroll
          for (int k = 0; k < 4; ++k) { const size_t j = i + k * st; if (j < n4) o[j] = pg8::cvt_pk4_fp8(v[k][0] * A8_SCALE, v[k][1] * A8_SCALE, v[k][2] * A8_SCALE, v[k][3] * A8_SCALE); } } }
    { const float* w = (const float*)A.in[11]; bf16* o = (bf16*)(F.ws + WS_CWS); const int n = 2 * 16 * 128 * 128;
      for (int i = F.c * NT + F.tid; i < n / 2; i += F.G * NT) { const int e = 2 * i, t = (e >> 7) & 127, s = e & 127; const float a = (s <= t) ? w[e] : 0.f, b = (s + 1 <= t) ? w[e + 1] : 0.f; ((unsigned*)o)[i] = pk2(a, b); } }
}

__device__ __forceinline__ void rmsnorm_phase(Frame& F, const float* xf, const float* PS, float* RSTD, bf16* H, unsigned char* H8) {
    OPAQUE_TID();
    const int gw = F.c * NWAVES + F.wave, NGW = F.G * NWAVES;
    if (xf) {
        for (int m = gw; m < MROWS; m += NGW) {
            const f32x4* xr = (const f32x4*)(xf + (size_t)m * DM) + F.lane; f32x4 v[16]; float ss = 0.f;
#pragma unroll
            for (int j = 0; j < 16; ++j) { v[j] = xr[64 * j]; ss += (v[j][0] * v[j][0] + v[j][1] * v[j][1]) + (v[j][2] * v[j][2] + v[j][3] * v[j][3]); }
            const float rstd = rsqrtf(wave_sum(ss, F.lane) * (1.0f / DM) + NORM_EPS);
            if (F.lane == 0) RSTD[m] = rstd;
            u32x2* o = (u32x2*)(H + (size_t)m * DM) + F.lane; unsigned* o8 = (unsigned*)(H8 + (size_t)m * DM) + F.lane;
#pragma unroll
            for (int j = 0; j < 16; ++j) { o8[64 * j] = pg8::cvt_pk4_fp8(v[j][0], v[j][1], v[j][2], v[j][3]); u32x2 w; w.x = pk2(v[j][0], v[j][1]); w.y = pk2(v[j][2], v[j][3]); o[64 * j] = w; }
        }
    } else {
        for (int m = F.c * NT + F.tid; m < MROWS; m += F.G * NT) {
            const f32x4* p = (const f32x4*)(PS + (size_t)m * 64); f32x4 pv[16];
#pragma unroll
            for (int j = 0; j < 16; ++j) pv[j] = p[j];
            asm volatile("" : "+v"(pv[0]), "+v"(pv[1]), "+v"(pv[2]), "+v"(pv[3]), "+v"(pv[4]), "+v"(pv[5]), "+v"(pv[6]), "+v"(pv[7]), "+v"(pv[8]), "+v"(pv[9]), "+v"(pv[10]), "+v"(pv[11]), "+v"(pv[12]), "+v"(pv[13]), "+v"(pv[14]), "+v"(pv[15]));
            f32x4 a = pv[0];
#pragma unroll
            for (int j = 1; j < 16; ++j) a = a + pv[j];
            RSTD[m] = rsqrtf(((a[0] + a[1]) + (a[2] + a[3])) * (1.0f / DM) + NORM_EPS);
        }
    }
}
__device__ __forceinline__ void prep_even_phase(Frame& F, bf16* Z, const float* akn) {
    OPAQUE_TID();
    const int gw = F.c * NWAVES + F.wave, NGW = F.G * NWAVES, l = F.lane, li = l & 15;
    const f32x4 ga = *(const f32x4*)(akn + 8 * li), gb = *(const f32x4*)(akn + 8 * li + 4);
    for (int m4 = gw; m4 < MROWS / 4; m4 += NGW) {
        u32x4* p = (u32x4*)(Z + (size_t)(4 * m4 + (l >> 4)) * LDZE + ZE_KA + 8 * li); const u32x4 w = *p; float v[8];
#pragma unroll
        for (int e = 0; e < 4; ++e) { v[2 * e] = bflo(w[e]); v[2 * e + 1] = bfhi(w[e]); }
        float ss = 0.f;
#pragma unroll
        for (int e = 0; e < 8; ++e) ss += v[e] * v[e];
        ss += shx(ss, 1, l); ss += shx(ss, 2, l); ss += shx(ss, 4, l); ss += shx(ss, 8, l);
        const float rstd = rsqrtf(ss * (1.0f / 128.0f) + NORM_EPS);
        u32x4 o; o.x = pk2(v[0] * rstd * ga[0], v[1] * rstd * ga[1]); o.y = pk2(v[2] * rstd * ga[2], v[3] * rstd * ga[3]); o.z = pk2(v[4] * rstd * gb[0], v[5] * rstd * gb[1]); o.w = pk2(v[6] * rstd * gb[2], v[7] * rstd * gb[3]);
        *p = o;
    }
}
__device__ __forceinline__ void prep_odd1_phase(Frame& F, const bf16* Z, const float* qlg, const float* kvlg, unsigned char* CQN, unsigned char* CKVN, float* STATS) {
    OPAQUE_TID();
    const int gw = F.c * NWAVES + F.wave, NGW = F.G * NWAVES, l = F.lane;
    u32x4 cur[8], nxt[8];
#define PO_LOAD(dst, m_) do { const bf16* zr_ = Z + (size_t)(m_) * LDZO; _Pragma("unroll") for (int j = 0; j < 3; ++j) dst[j] = ((const u32x4*)(zr_ + ZO_CQ + 24 * l))[j]; dst[3] = *(const u32x4*)(zr_ + ZO_CKV + 8 * l); \
        _Pragma("unroll") for (int j = 0; j < 4; ++j) dst[4 + j] = ((const u32x4*)(zr_ + ZO_CV + 32 * l))[j]; } while (0)
    f32x4 gq[6], gkv[2];
#pragma unroll
    for (int j = 0; j < 6; ++j) gq[j] = ((const f32x4*)(qlg + 24 * l))[j];
    gkv[0] = *(const f32x4*)(kvlg + 8 * l); gkv[1] = *(const f32x4*)(kvlg + 8 * l + 4);
    if (gw < MROWS) PO_LOAD(cur, gw);
    for (int m = gw; m < MROWS; m += NGW) {
        const bool more = (m + NGW < MROWS);
        if (more) PO_LOAD(nxt, m + NGW);
        { float v[24]; float ss = 0.f;
#pragma unroll
          for (int j = 0; j < 3; ++j)
#pragma unroll
              for (int e = 0; e < 4; ++e) { v[8 * j + 2 * e] = bflo(cur[j][e]); v[8 * j + 2 * e + 1] = bfhi(cur[j][e]); }
#pragma unroll
          for (int e = 0; e < 24; ++e) ss += v[e] * v[e];
          const float rstd = rsqrtf(wave_sum(ss, l) * (1.0f / 1536.0f) + NORM_EPS) * A8_SCALE; u32x2* o = (u32x2*)(CQN + (size_t)m * 1536 + 24 * l);
#pragma unroll
          for (int j = 0; j < 3; ++j) { const f32x4 ga = gq[2 * j], gb = gq[2 * j + 1]; u32x2 w;
              w.x = pg8::cvt_pk4_fp8(v[8 * j + 0] * rstd * ga[0], v[8 * j + 1] * rstd * ga[1], v[8 * j + 2] * rstd * ga[2], v[8 * j + 3] * rstd * ga[3]);
              w.y = pg8::cvt_pk4_fp8(v[8 * j + 4] * rstd * gb[0], v[8 * j + 5] * rstd * gb[1], v[8 * j + 6] * rstd * gb[2], v[8 * j + 7] * rstd * gb[3]); o[j] = w; } }
        { float v[8]; float ss = 0.f;
#pragma unroll
          for (int e = 0; e < 4; ++e) { v[2 * e] = bflo(cur[3][e]); v[2 * e + 1] = bfhi(cur[3][e]); }
#pragma unroll
          for (int e = 0; e < 8; ++e) ss += v[e] * v[e];
          const float rstd = rsqrtf(wave_sum(ss, l) * (1.0f / 512.0f) + NORM_EPS) * A8_SCALE; const f32x4 ga = gkv[0], gb = gkv[1];
          u32x2 o; o.x = pg8::cvt_pk4_fp8(v[0] * rstd * ga[0], v[1] * rstd * ga[1], v[2] * rstd * ga[2], v[3] * rstd * ga[3]); o.y = pg8::cvt_pk4_fp8(v[4] * rstd * gb[0], v[5] * rstd * gb[1], v[6] * rstd * gb[2], v[7] * rstd * gb[3]);
          *(u32x2*)(CKVN + (size_t)m * 512 + 8 * l) = o; }
        { float v[32]; float s1 = 0.f;
#pragma unroll
          for (int j = 0; j < 4; ++j)
#pragma unroll
              for (int e = 0; e < 4; ++e) { v[8 * j + 2 * e] = fgelu(bflo(cur[4 + j][e])); v[8 * j + 2 * e + 1] = fgelu(bfhi(cur[4 + j][e])); }
#pragma unroll
          for (int e = 0; e < 32; ++e) s1 += v[e];
          const float mean = wave_sum(s1, l) * (1.0f / 2048.0f); float s2 = 0.f;
#pragma unroll
          for (int e = 0; e < 32; ++e) { const float d = v[e] - mean; s2 += d * d; }
          const float rstd = rsqrtf(wave_sum(s2, l) * (1.0f / 2048.0f) + NORM_EPS);
          if (l == 0) { f32x2 st; st.x = mean; st.y = rstd; *(f32x2*)(STATS + 2 * (size_t)m) = st; } }
#pragma unroll
        for (int j = 0; j < 8; ++j) cur[j] = nxt[j];
    }
#undef PO_LOAD
}
__device__ __forceinline__ void prep_odd2_phase(Frame& F, bf16* QF, const bf16* KVF, const bf16* Z, bf16* KM, const int* pos, const float* qn, const float* kn) {
    OPAQUE_TID();
    (void)QF; (void)qn;
    const int gw = F.c * NWAVES + F.wave, NGW = F.G * NWAVES, l = F.lane, hd = l >> 2, pl = l & 3;
    float invf[8];
#pragma unroll
    for (int e = 0; e < 8; ++e) invf[e] = exp2f(-(float)(8 * pl + e) * (13.287712379549449f / 32.0f));
    f32x4 gk[8], r1a, r1b, r2a, r2b;
#pragma unroll
    for (int j = 0; j < 8; ++j) gk[j] = ((const f32x4*)(kn + 32 * pl))[j];
    r1a = *(const f32x4*)(kn + 128 + 8 * pl); r1b = *(const f32x4*)(kn + 132 + 8 * pl); r2a = *(const f32x4*)(kn + 160 + 8 * pl); r2b = *(const f32x4*)(kn + 164 + 8 * pl);
    u32x4 cur[6], nxt[6]; int pcur = 0, pnxt = 0;
#define P2_LOAD(dst, pd, m_) do { const bf16* k_ = KVF + (size_t)(m_) * 4096 + hd * 256; const bf16* r_ = Z + (size_t)(m_) * LDZO + ZO_KR; \
        _Pragma("unroll") for (int j = 0; j < 4; ++j) dst[j] = ((const u32x4*)(k_ + 32 * pl))[j]; \
        dst[4] = *(const u32x4*)(r_ + 8 * pl); dst[5] = *(const u32x4*)(r_ + 32 + 8 * pl); pd = pos[m_]; } while (0)
    if (gw < MROWS) P2_LOAD(cur, pcur, gw);
    for (int m = gw; m < MROWS; m += NGW) {
        const bool more = (m + NGW < MROWS);
        if (more) P2_LOAD(nxt, pnxt, m + NGW);
        const float fp = (float)pcur;
        float cs[8], sn[8];
#pragma unroll
        for (int e = 0; e < 8; ++e) { const float ang = fp * invf[e]; float tr = ang * 0.15915494309189535f; tr = tr - floorf(tr); sn[e] = __builtin_amdgcn_sinf(tr); cs[e] = __builtin_amdgcn_cosf(tr); }
        {
            bf16* dst = KM + ((size_t)((m >> 11) * 16 + hd) * SEQ + (m & (SEQ - 1))) * 192;
            float v[32], a1[8], a2[8]; float ss = 0.f;
#pragma unroll
            for (int j = 0; j < 4; ++j)
#pragma unroll
                for (int e = 0; e < 4; ++e) { const unsigned w = cur[j][e]; v[8 * j + 2 * e] = bflo(w); v[8 * j + 2 * e + 1] = bfhi(w); }
#pragma unroll
            for (int e = 0; e < 4; ++e) { const unsigned w1 = cur[4][e], w2 = cur[5][e]; a1[2 * e] = bflo(w1); a1[2 * e + 1] = bfhi(w1); a2[2 * e] = bflo(w2); a2[2 * e + 1] = bfhi(w2); }
#pragma unroll
            for (int e = 0; e < 32; ++e) ss += v[e] * v[e];
#pragma unroll
            for (int e = 0; e < 8; ++e) ss += a1[e] * a1[e] + a2[e] * a2[e];
            ss += shx(ss, 1, l); ss += shx(ss, 2, l);
            const float rstd = rsqrtf(ss * (1.0f / 192.0f) + NORM_EPS);
#pragma unroll
            for (int j = 0; j < 4; ++j) { const f32x4 ga = gk[2 * j], gb = gk[2 * j + 1]; u32x4 o;
                o.x = pk2(v[8 * j + 0] * rstd * ga[0], v[8 * j + 1] * rstd * ga[1]); o.y = pk2(v[8 * j + 2] * rstd * ga[2], v[8 * j + 3] * rstd * ga[3]);
                o.z = pk2(v[8 * j + 4] * rstd * gb[0], v[8 * j + 5] * rstd * gb[1]); o.w = pk2(v[8 * j + 6] * rstd * gb[2], v[8 * j + 7] * rstd * gb[3]); ((u32x4*)(dst + 32 * pl))[j] = o; }
            float o1[8], o2[8];
#pragma unroll
            for (int e = 0; e < 8; ++e) { const float g1 = e < 4 ? r1a[e & 3] : r1b[e & 3], g2 = e < 4 ? r2a[e & 3] : r2b[e & 3]; const float y1 = a1[e] * rstd * g1, y2 = a2[e] * rstd * g2; o1[e] = y1 * cs[e] - y2 * sn[e]; o2[e] = y1 * sn[e] + y2 * cs[e]; }
            u32x4 w1, w2; w1.x = pk2(o1[0], o1[1]); w1.y = pk2(o1[2], o1[3]); w1.z = pk2(o1[4], o1[5]); w1.w = pk2(o1[6], o1[7]); w2.x = pk2(o2[0], o2[1]); w2.y = pk2(o2[2], o2[3]); w2.z = pk2(o2[4], o2[5]); w2.w = pk2(o2[6], o2[7]);
            *(u32x4*)(dst + 128 + 8 * pl) = w1; *(u32x4*)(dst + 160 + 8 * pl) = w2;
        }
#pragma unroll
        for (int j = 0; j < 6; ++j) cur[j] = nxt[j];
        pcur = pnxt;
    }
#undef P2_LOAD
}
__device__ __forceinline__ void indexer_phase(Frame& F, const bf16* Z, unsigned* MASK, float* SCR) {
    OPAQUE_TID();
    const int tid = F.tid, l = F.lane, w = F.wave, li = l & 15, g = l >> 4;
    LAS unsigned char* iql = F.lds;
    LAS float* wl = (LAS float*)(F.lds + 65536);
    float* scr = SCR + (size_t)F.c * (16 * 2048);
    for (int r = 0;; ++r) {
        const int u = r * F.G + F.c; if (u >= BATCH * 128) break;
        const int b = u >> 7; int qg = u & 127; if (r & 1) qg = 127 - qg;
        const int t0 = qg * 16; const size_t row0 = (size_t)b * SEQ;
        { u32x4 iv[8];
#pragma unroll
          for (int r8 = 0; r8 < 8; ++r8) { const int ci = tid + 512 * r8, q = ci >> 8, hc = ci & 255, h = hc >> 4, c8 = hc & 15;
              iv[r8] = *(const u32x4*)(Z + (row0 + t0 + q) * LDZE + ZE_IQ + h * 128 + c8 * 8); }
          asm volatile("" : "+v"(iv[0]), "+v"(iv[1]), "+v"(iv[2]), "+v"(iv[3]), "+v"(iv[4]), "+v"(iv[5]), "+v"(iv[6]), "+v"(iv[7]));
#pragma unroll
          for (int r8 = 0; r8 < 8; ++r8) { const int ci = tid + 512 * r8, q = ci >> 8, hc = ci & 255, h = hc >> 4, c8 = hc & 15;
              *(LAS u32x4*)(iql + (h * 4 + (c8 >> 2)) * 1024 + ((c8 & 3) * 16 + q) * 16) = iv[r8]; } }
        if (tid < 256) { const int q = tid >> 4, h = tid & 15; wl[h * 16 + q] = __uint_as_float((unsigned)Z[(row0 + t0 + q) * LDZE + ZE_IW + h] << 16) * 0.022097086912079608f; }
        __syncthreads();
        const int ngrp = (qg + 4) >> 2;
        bf16x8 a[4][4], an[2][4];
#define IX_LOAD(dst, grp_, t0_, nt_) do { _Pragma("unroll") for (int tl = 0; tl < (nt_); ++tl) _Pragma("unroll") for (int kk = 0; kk < 4; ++kk) \
            dst[tl][kk] = *(const bf16x8*)(Z + (row0 + (grp_) * 64 + ((t0_) + tl) * 16 + li) * LDZE + ZE_IK + kk * 32 + 8 * g); } while (0)
        if (w < ngrp) IX_LOAD(a, w, 0, 4);
        for (int grp = w; grp < ngrp; grp += 8) {
            const bool nx = (grp + 8 < ngrp);
            if (nx) IX_LOAD(an, grp + 8, 0, 2);
            f32x4 sc[4];
#pragma unroll
            for (int tl = 0; tl < 4; ++tl) sc[tl] = (f32x4){0.f, 0.f, 0.f, 0.f};
#pragma unroll 2
            for (int h = 0; h < 16; ++h) {
                const float wq = wl[h * 16 + li];
                bf16x8 bq[4];
#pragma unroll
                for (int kk = 0; kk < 4; ++kk) bq[kk] = *(const LAS bf16x8*)(iql + (h * 4 + kk) * 1024 + l * 16);
#pragma unroll
                for (int tl = 0; tl < 4; ++tl) { f32x4 acc = (f32x4){0.f, 0.f, 0.f, 0.f};
#pragma unroll
                    for (int kk = 0; kk < 4; ++kk) acc = MFMA16(a[tl][kk], bq[kk], acc);
#pragma unroll
                    for (int e = 0; e < 4; ++e) sc[tl][e] += wq * fmaxf(acc[e], 0.f); }
            }
#pragma unroll
            for (int tl = 0; tl < 4; ++tl) *(f32x4*)(scr + li * 2048 + grp * 64 + tl * 16 + 4 * g) = sc[tl];
            if (nx) {
#pragma unroll
                for (int tl = 0; tl < 2; ++tl)
#pragma unroll
                    for (int kk = 0; kk < 4; ++kk) a[tl][kk] = an[tl][kk];
#pragma unroll
                for (int tl = 0; tl < 2; ++tl)
#pragma unroll
                    for (int kk = 0; kk < 4; ++kk) a[2 + tl][kk] = *(const bf16x8*)(Z + (row0 + (grp + 8) * 64 + (2 + tl) * 16 + li) * LDZE + ZE_IK + kk * 32 + 8 * g);
            }
        }
#undef IX_LOAD
        VM_WAIT(); __syncthreads();
#pragma unroll 1
        for (int qq = 0; qq < 2; ++qq) {
            const int qi = 2 * w + qq, t = t0 + qi, n = t + 1, nch = (n + 63) >> 6;
            unsigned uk[32];
#pragma unroll
            for (int c = 0; c < 32; ++c) { unsigned x = 0u;
                { const int key = c * 64 + l; const unsigned bits = __float_as_uint(scr[qi * 2048 + key]); const unsigned ord = bits ^ ((bits >> 31) ? 0xffffffffu : 0x80000000u); x = (key <= t) ? ord : 0u; }
                uk[c] = x; }
            unsigned T = 1u;
            if (n > 256) { T = 0u;
#pragma unroll 1
                for (int bit = 31; bit >= 0; --bit) { const unsigned cand = T | (1u << bit); int cnt = 0;
#pragma unroll
                    for (int c = 0; c < 32; ++c) cnt += __popcll(__ballot(uk[c] >= cand));
                    if (cnt >= 256) { T = cand; if (cnt == 256) break; } } }
            unsigned lo = 0u, hi = 0u;
#pragma unroll
            for (int c = 0; c < 32; ++c) { const unsigned long long bal = __ballot(uk[c] >= T); if (l == c) { lo = (unsigned)bal; hi = (unsigned)(bal >> 32); } }
            if (l < 32) { u32x2 mw; mw.x = lo; mw.y = hi; *(u32x2*)(MASK + (row0 + t) * 64 + 2 * l) = mw; }
        }
        __syncthreads();
    }
}

__device__ __forceinline__ void glds16(const void* gsrc, unsigned lds_dst) { unsigned keep;
    asm volatile("s_mov_b32 %0, m0\n\ts_mov_b32 m0, %2\n\ts_nop 0\n\tglobal_load_lds_dwordx4 %1, off\n\ts_mov_b32 m0, %0" : "=&s"(keep) : "v"(gsrc), "s"(lds_dst) : "memory"); }
#define ATT_WAIT_BAR(N) asm volatile("s_waitcnt vmcnt(" #N ") lgkmcnt(0)\n\ts_barrier" ::: "memory")
template <int MODE> struct AC;
template <> struct AC<0> { static constexpr int DQK = 128, DV = 128, NSUB = 2, NU = 1024; };
template <> struct AC<1> { static constexpr int DQK = 192, DV = 128, NSUB = 2, NU = 1024; };
template <> struct AC<2> { static constexpr int DQK = 256, DV = 256, NSUB = 1, NU = 1024; };
struct AttnP { const bf16* q; int qs; const bf16* k; int ks; const bf16* v; int vs; const bf16* gate; int gs; unsigned char* mix; const int* pos; const unsigned* mask; const float* gn; const float* gk; };

template <int MODE>
__device__ __forceinline__ void attn_phase(Frame& F, const AttnP P) {
    constexpr int DQK = AC<MODE>::DQK, DV = AC<MODE>::DV, NSUB = AC<MODE>::NSUB, NU = AC<MODE>::NU;
    constexpr int KK = DQK / 32, NDT = DV / 16, KCH = DQK / 8, VCH = DV / 8, NKC = 64 * KCH / NT, NVC = 64 * VCH / NT, KT = 64 * DQK * 2, VT = 64 * DV * 2, BUFB = KT + VT;
    constexpr float QC1 = (MODE == 0) ? 0.08838834764831845f * 1.4426950408889634f : (MODE == 1 ? 0.07216878364870322f * 1.4426950408889634f : 1.0f);
    constexpr int QPW = (MODE == 1) ? 32 : 16;
    constexpr int NBUF = 3, NKF = 4 * KK, NPIECE = NKF + 2 * NDT, NPW = NPIECE / NWAVES;
    static_assert(NPIECE % NWAVES == 0 && NKF % NWAVES == 0 && (NPW == 4 || NPW == 5), "piece deal");
    static_assert(NBUF * BUFB + (MODE == 0 ? 4096 + 8192 : 0) <= RING_BYTES, "attention LDS");
    OPAQUE_TID();
    const int tid = F.tid, l = F.lane, w = F.wave, li = l & 15, g = l >> 4;
    LAS unsigned char* lds = F.lds;
    LAS unsigned* mlds = (LAS unsigned*)(lds + NBUF * BUFB);
    LAS int* plds = (LAS int*)(lds + NBUF * BUFB + 4096);
    const unsigned lds0 = (unsigned)(__UINTPTR_TYPE__)lds;
    const float NEG_INF = -__builtin_inff();
    bf16x8 ones8; { const u32x4 o1 = {0x3f803f80u, 0x3f803f80u, 0x3f803f80u, 0x3f803f80u}; ones8 = __builtin_bit_cast(bf16x8, o1); }
    for (int r = 0;; ++r) {
        const int u = r * F.G + F.vc; if (u >= NU) break;
        int b, h = 0, tq0, qbase, nkt;
        if (MODE == 0) { b = u >> 7; int qg = u & 127; if (r & 1) qg = 127 - qg; tq0 = qg * 16; qbase = tq0; nkt = (qg >> 2) + 1; }
        else if (MODE == 1) { const int bh = u >> 3; int qb = u & 7; if (r & 1) qb = 7 - qb; tq0 = qb * 256; qbase = tq0 + 32 * w; nkt = 4 * (qb + 1); b = bh >> 4; h = bh & 15; }
        else { const int bh = u >> 4; int qb = u & 15; if (r & 1) qb = 15 - qb; tq0 = qb * 128; qbase = tq0 + 16 * w; nkt = 2 * (qb + 1); b = bh >> 3; h = bh & 7; }
        const size_t row0 = (size_t)b * SEQ;
        int tqs[NSUB];
#pragma unroll
        for (int s = 0; s < NSUB; ++s) tqs[s] = qbase + li + ((MODE == 1) ? 16 * s : 0);
        const int hoff = (MODE == 0) ? 0 : (MODE == 1 ? h * 192 : h * 256), hoffv = (MODE == 0) ? 0 : h * 256;
        const bf16* kb = (MODE == 1) ? P.k + (size_t)((b * 16 + h) * SEQ) * P.ks : P.k + row0 * P.ks + hoff;
        const bf16* vb = P.v + row0 * P.vs + hoffv;
        bf16x8 qf[NSUB][KK];
#pragma unroll
        for (int s = 0; s < NSUB; ++s) { const bf16* qp = P.q + (row0 + tqs[s]) * P.qs + ((MODE == 0) ? (2 * w + s) * 128 : hoff) + 8 * g;
#pragma unroll
            for (int kk = 0; kk < KK; ++kk) qf[s][kk] = *(const bf16x8*)(qp + kk * 32); }
        float qnorm[NSUB];
#pragma unroll
        for (int s = 0; s < NSUB; ++s) qnorm[s] = 0.f;
        if (MODE == 0) {
            f32x4 qg8[KK][2];
#pragma unroll
            for (int kk = 0; kk < KK; ++kk) { qg8[kk][0] = *(const f32x4*)(P.gn + kk * 32 + 8 * g); qg8[kk][1] = *(const f32x4*)(P.gn + kk * 32 + 8 * g + 4); }
#pragma unroll
            for (int s = 0; s < NSUB; ++s) { float qv[KK][8]; float ss = 0.f;
#pragma unroll
                for (int kk = 0; kk < KK; ++kk) { const u32x4 wq = __builtin_bit_cast(u32x4, qf[s][kk]);
#pragma unroll
                    for (int e = 0; e < 4; ++e) { qv[kk][2 * e] = bflo(wq[e]); qv[kk][2 * e + 1] = bfhi(wq[e]); ss += qv[kk][2 * e] * qv[kk][2 * e] + qv[kk][2 * e + 1] * qv[kk][2 * e + 1]; } }
                ss = xsum32(xsum16(ss)); const float rstd = rsqrtf(ss * (1.0f / 128.0f) + NORM_EPS);
                float q2 = 0.f;
#pragma unroll
                for (int kk = 0; kk < KK; ++kk) { const f32x4 ga = qg8[kk < 4 ? kk : 0][0], gb = qg8[kk < 4 ? kk : 0][1]; u32x4 wq;
#pragma unroll
                    for (int e = 0; e < 8; ++e) { qv[kk][e] *= rstd * (e < 4 ? ga[e & 3] : gb[e & 3]); q2 += qv[kk][e] * qv[kk][e]; }
                    wq.x = pk2(qv[kk][0] * QC1, qv[kk][1] * QC1); wq.y = pk2(qv[kk][2] * QC1, qv[kk][3] * QC1); wq.z = pk2(qv[kk][4] * QC1, qv[kk][5] * QC1); wq.w = pk2(qv[kk][6] * QC1, qv[kk][7] * QC1); qf[s][kk] = __builtin_bit_cast(bf16x8, wq); }
                qnorm[s] = sqrtf(xsum32(xsum16(q2))); } }
        if (MODE == 1) {
#pragma unroll
            for (int s = 0; s < NSUB; ++s) { float qv[KK][8]; float ss = 0.f;
#pragma unroll
                for (int kk = 0; kk < KK; ++kk) { const u32x4 wq = __builtin_bit_cast(u32x4, qf[s][kk]);
#pragma unroll
                    for (int e = 0; e < 4; ++e) { qv[kk][2 * e] = bflo(wq[e]); qv[kk][2 * e + 1] = bfhi(wq[e]); ss += qv[kk][2 * e] * qv[kk][2 * e] + qv[kk][2 * e + 1] * qv[kk][2 * e + 1]; } }
                ss = xsum32(xsum16(ss)); const float rstd = rsqrtf(ss * (1.0f / 192.0f) + NORM_EPS); const float fp = (float)P.pos[row0 + tqs[s]];
#pragma unroll
                for (int kk = 0; kk < KK; ++kk) { const f32x4 ga = *(const f32x4*)(P.gn + kk * 32 + 8 * g), gb = *(const f32x4*)(P.gn + kk * 32 + 8 * g + 4);
#pragma unroll
                    for (int e = 0; e < 8; ++e) qv[kk][e] *= rstd * (e < 4 ? ga[e & 3] : gb[e & 3]); }
#pragma unroll
                for (int e = 0; e < 8; ++e) { const float inv = exp2f(-(float)(8 * g + e) * (13.287712379549449f / 32.0f)); float tr = fp * inv * 0.15915494309189535f; tr = tr - floorf(tr);
                    const float sn = __builtin_amdgcn_sinf(tr), cs = __builtin_amdgcn_cosf(tr), y1 = qv[4][e], y2 = qv[5][e]; qv[4][e] = y1 * cs - y2 * sn; qv[5][e] = y1 * sn + y2 * cs; }
                float q2 = 0.f;
#pragma unroll
                for (int kk = 0; kk < KK; ++kk) { u32x4 wq; wq.x = pk2(qv[kk][0] * QC1, qv[kk][1] * QC1); wq.y = pk2(qv[kk][2] * QC1, qv[kk][3] * QC1); wq.z = pk2(qv[kk][4] * QC1, qv[kk][5] * QC1); wq.w = pk2(qv[kk][6] * QC1, qv[kk][7] * QC1); qf[s][kk] = __builtin_bit_cast(bf16x8, wq);
#pragma unroll
                    for (int e = 0; e < 8; ++e) q2 += qv[kk][e] * qv[kk][e];
                    asm volatile("" : "+v"(qf[s][kk])); }
                qnorm[s] = sqrtf(xsum32(xsum16(q2))); } }
        float c1, slope2[NSUB], cst[NSUB], lg = 0.f; int pos_t = 0;
#pragma unroll
        for (int s = 0; s < NSUB; ++s) cst[s] = 0.f;
        if (MODE == 0) { c1 = 0.08838834764831845f * 1.4426950408889634f; pos_t = P.pos[row0 + tqs[0]];
#pragma unroll
            for (int s = 0; s < NSUB; ++s) slope2[s] = __builtin_amdgcn_exp2f(-0.5f * (float)(2 * w + s + 1)) * 1.4426950408889634f; }
        else if (MODE == 1) { c1 = 0.07216878364870322f * 1.4426950408889634f;
            float gm = fmaxf(fmaxf(fabsf(P.gk[l]), fabsf(P.gk[64 + l])), fabsf(P.gk[128 + l]));
#pragma unroll
            for (int o_ = 1; o_ < 64; o_ <<= 1) gm = fmaxf(gm, shx(gm, o_, l));
#pragma unroll
            for (int s = 0; s < NSUB; ++s) { slope2[s] = 0.f; cst[s] = -(qnorm[s] * 13.86f * gm * 1.01f) * c1; } }
        else { c1 = 0.0625f; slope2[0] = 0.f; lg = log2f(1.0f - exp2f(-5.0f - (float)h)); }
        f32x4 o[NSUB][NDT], ol[NSUB];
#pragma unroll
        for (int s = 0; s < NSUB; ++s) { ol[s] = (f32x4){0.f, 0.f, 0.f, 0.f};
#pragma unroll
            for (int dt = 0; dt < NDT; ++dt) o[s][dt] = (f32x4){0.f, 0.f, 0.f, 0.f}; }
        if (MODE == 0) { unsigned mw[2]; int pw[4];
#pragma unroll
                         for (int k = 0; k < 2; ++k) { const int i = tid + NT * k; mw[k] = P.mask[(row0 + tq0 + (i >> 6)) * 64 + (i & 63)]; }
#pragma unroll
                         for (int k = 0; k < 4; ++k) pw[k] = P.pos[row0 + tid + NT * k];
                         asm volatile("" : "+v"(mw[0]), "+v"(mw[1]), "+v"(pw[0]), "+v"(pw[1]), "+v"(pw[2]), "+v"(pw[3]));
#pragma unroll
                         for (int k = 0; k < 2; ++k) mlds[tid + NT * k] = mw[k];
#pragma unroll
                         for (int k = 0; k < 4; ++k) plds[tid + NT * k] = pw[k]; }
        constexpr int KB_OFF = 16384;
        const int r4 = l >> 4, s16 = l & 15, r8 = l >> 3, s8 = l & 7;
        const unsigned laneKA = (unsigned)(r4 * P.ks + ((s16 ^ (4 * (w & 3) + r4)) << 3));
        const unsigned laneKB = (unsigned)(r8 * P.ks + 128 + ((s8 ^ (4 * (w & 1) + (r8 >> 1))) << 3));
        const unsigned laneV = (unsigned)(r4 * P.vs + (((s16 >> 1) ^ (4 * (w & 1) + r4)) << 4) + ((s16 & 1) << 3));
        constexpr int JV0 = NPW - 2;
        unsigned kxa[4], kxb[2], vx[NDT];
#pragma unroll
        for (int kk = 0; kk < 4; ++kk) kxa[kk] = (unsigned)(li * 256 + (((kk * 4 + g) ^ li) << 4));
#pragma unroll
        for (int i = 0; i < 2; ++i) kxb[i] = (unsigned)(KB_OFF + li * 128 + (((i * 4 + g) ^ (li >> 1)) << 4));
#pragma unroll
        for (int dt = 0; dt < NDT; ++dt) vx[dt] = (unsigned)(KT + (4 * g + (li >> 2)) * 256 + ((dt ^ (4 * (g & 1) + (li >> 2))) << 5) + (li & 3) * 8);
#define ATT_DMA(kt_, buf_) do { const bf16* tk_ = kb + (size_t)(kt_) * 64 * P.ks; const bf16* tv_ = vb + (size_t)(kt_) * 64 * P.vs; const unsigned bb_ = lds0 + (unsigned)(buf_) * BUFB; \
        _Pragma("unroll") for (int j = 0; j < NPW; ++j) { \
            if (j < 2) { const int pa = w + 8 * j; glds16(tk_ + (size_t)(4 * pa) * P.ks + laneKA, (unsigned)__builtin_amdgcn_readfirstlane(bb_ + pa * 1024)); } \
            else if (j < JV0) { glds16(tk_ + (size_t)(8 * w) * P.ks + laneKB, (unsigned)__builtin_amdgcn_readfirstlane(bb_ + KB_OFF + w * 1024)); } \
            else { const int pv = w + 8 * (j - JV0); glds16(tv_ + (size_t)(4 * pv) * P.vs + laneV, (unsigned)__builtin_amdgcn_readfirstlane(bb_ + KT + pv * 1024)); } } } while (0)
        ATT_DMA(0, 0);
        if (nkt > 1) { ATT_DMA(1, 1); if (NPW == 4) ATT_WAIT_BAR(4); else ATT_WAIT_BAR(5); } else ATT_WAIT_BAR(0);
        if (MODE == 0) {
            float gm = fmaxf(fabsf(P.gk[l]), fabsf(P.gk[64 + l]));
#pragma unroll
            for (int o_ = 1; o_ < 64; o_ <<= 1) gm = fmaxf(gm, shx(gm, o_, l));
            int wi = tqs[0] >> 5; unsigned wd = mlds[li * 64 + wi];
            while (wd == 0u && wi > 0) { --wi; wd = mlds[li * 64 + wi]; }
            const int smax = wi * 32 + 31 - __builtin_clz(wd | 1u);
            const float dmin = (float)(pos_t - plds[smax]);
#pragma unroll
            for (int s = 0; s < NSUB; ++s) cst[s] = -c1 * (qnorm[s] * 11.3137085f * gm * 1.01f) + slope2[s] * dmin;
        }
        if (w >= 4) __builtin_amdgcn_s_setprio(1);
        int bcur = 0, bnxt2 = 2;
        for (int kt = 0; kt < nkt; ++kt) {
            const bool more2 = (kt + 2 < nkt);
            if (more2) ATT_DMA(kt + 2, bnxt2);
            const LAS unsigned char* Kb = lds + bcur * BUFB; const LAS unsigned char* Vb = Kb + KT;
            bool active = true, need_mask = true;
            if (MODE != 0) { const int k0 = kt * 64; active = (k0 <= qbase + QPW - 1); need_mask = (k0 + 63 > qbase); }
            if (active) {
                f32x4 st2[2][NSUB][2]; bf16x8 pf2[2][NSUB]; float xs[NSUB][8];
                float dist[8]; unsigned em[8] = {0xffffffffu, 0xffffffffu, 0xffffffffu, 0xffffffffu, 0xffffffffu, 0xffffffffu, 0xffffffffu, 0xffffffffu};
                constexpr int NQ = 2 * KK, NE = NSUB * 8;
                auto k_read = [&](const int n) __attribute__((always_inline)) -> bf16x8 {
                    const int h32 = n / NQ, i = n % NQ, t16 = i / KK, kk = i % KK;
                    return (kk < 4) ? *(const LAS bf16x8*)(Kb + (h32 * 2 + t16) * 4096 + kxa[kk < 4 ? kk : 0]) : *(const LAS bf16x8*)(Kb + (h32 * 2 + t16) * 2048 + kxb[kk < 4 ? 0 : kk - 4]); };
                auto qk_mma = [&](const int n, const bf16x8 a) __attribute__((always_inline)) { const int h32 = n / NQ, i = n % NQ, t16 = i / KK, kk = i % KK;
#pragma unroll
                    for (int s = 0; s < NSUB; ++s) st2[h32][s][t16] = MFMA16(a, qf[s][kk], st2[h32][s][t16]); };
                auto sm_pre = [&](const int h32) __attribute__((always_inline)) {
                    if (MODE == 0) { const int key0 = kt * 64 + h32 * 32 + 4 * g; const i32x4 p0 = *(const LAS i32x4*)(plds + key0), p1 = *(const LAS i32x4*)(plds + key0 + 16);
#pragma unroll
                        for (int e = 0; e < 4; ++e) { dist[e] = (float)(pos_t - p0[e]); dist[4 + e] = (float)(pos_t - p1[e]); }
                        const unsigned t = mlds[li * 64 + kt * 2 + h32] >> (4 * g);
#pragma unroll
                        for (int e = 0; e < 8; ++e) em[e] = (unsigned)__builtin_amdgcn_sbfe((int)t, (e >> 2) * 16 + (e & 3), 1); } };
                auto sm_elem = [&](const int h32, const int j) __attribute__((always_inline)) {
                    const int s = j >> 3, e = j & 7; const int key0 = kt * 64 + h32 * 32 + 4 * g; const float raw = st2[h32][s][e >> 2][e & 3]; float x;
                    if (MODE == 0) { const unsigned vb_ = __float_as_uint(raw - slope2[s] * dist[e]); x = __uint_as_float((vb_ & em[e]) | (~em[e] & 0xff800000u)); }
                    else if (MODE == 1) { const int key = key0 + (e >> 2) * 16 + (e & 3); x = (need_mask && key > tqs[s]) ? NEG_INF : raw; }
                    else { const int d = tqs[s] - (key0 + (e >> 2) * 16 + (e & 3)); const float v = raw * c1 * __builtin_amdgcn_exp2f((float)d * lg); x = (d >= 0) ? v : 0.f; }
                    if (MODE != 2) x = __builtin_amdgcn_exp2f(x);
                    xs[s][e] = x; };
                auto sm_fin = [&](const int h32) __attribute__((always_inline)) {
#pragma unroll
                    for (int s = 0; s < NSUB; ++s) { u32x4 pw; pw.x = pk2(xs[s][0], xs[s][1]); pw.y = pk2(xs[s][2], xs[s][3]); pw.z = pk2(xs[s][4], xs[s][5]); pw.w = pk2(xs[s][6], xs[s][7]);
                        pf2[h32][s] = __builtin_bit_cast(bf16x8, pw);
                        if (MODE != 2) ol[s] = MFMA16(ones8, pf2[h32][s], ol[s]); } };
                auto v_read = [&](const int m) __attribute__((always_inline)) -> bf16x8 { const LAS unsigned char* vp = Kb + (m / NDT) * 8192 + vx[m % NDT]; return cat8(tr_read(vp), tr_read(vp + 4096)); };
                auto pv_mma = [&](const int m, const bf16x8 a) __attribute__((always_inline)) {
#pragma unroll
                    for (int s = 0; s < NSUB; ++s) o[s][m % NDT] = MFMA16(a, pf2[m / NDT][s], o[s][m % NDT]); };
#pragma unroll
                for (int h = 0; h < 2; ++h)
#pragma unroll
                    for (int s = 0; s < NSUB; ++s) { const float c0 = (MODE != 2) ? cst[s] : 0.f; st2[h][s][0] = (f32x4){c0, c0, c0, c0}; st2[h][s][1] = (f32x4){c0, c0, c0, c0}; }
                bf16x8 kf[3], vf[2];
                kf[0] = k_read(0); kf[1] = k_read(1);
#pragma unroll
                for (int n = 0; n < 2 * NQ; ++n) {
                    if (n + 2 < 2 * NQ) kf[(n + 2) % 3] = k_read(n + 2);
                    if (n == NQ) sm_pre(0);
                    qk_mma(n, kf[n % 3]);
                    if (n >= NQ) {
#pragma unroll
                        for (int j = ((n - NQ) * NE) / NQ; j < ((n - NQ + 1) * NE) / NQ; ++j) sm_elem(0, j); }
                    __builtin_amdgcn_sched_barrier(0); }
                vf[0] = v_read(0);
                sm_fin(0);
                __builtin_amdgcn_sched_barrier(0);
                sm_pre(1);
#pragma unroll
                for (int m = 0; m < 2 * NDT; ++m) {
                    if (m + 1 < 2 * NDT) vf[(m + 1) & 1] = v_read(m + 1);
                    if (m == NDT) sm_fin(1);
                    pv_mma(m, vf[m & 1]);
                    if (m < NDT) {
#pragma unroll
                        for (int j = (m * NE) / NDT; j < ((m + 1) * NE) / NDT; ++j) sm_elem(1, j); }
                    __builtin_amdgcn_sched_barrier(0); }
            }
            if (more2) { if (NPW == 4) ATT_WAIT_BAR(4); else ATT_WAIT_BAR(5); } else ATT_WAIT_BAR(0);
            bcur = (bcur == NBUF - 1) ? 0 : bcur + 1; bnxt2 = (bnxt2 == NBUF - 1) ? 0 : bnxt2 + 1;
        }
#undef ATT_DMA
        __builtin_amdgcn_s_setprio(0);
        u32x2 gwv[NSUB][NDT];
#pragma unroll
        for (int s = 0; s < NSUB; ++s) { const size_t row = row0 + tqs[s]; const int hcol = (MODE == 0) ? (2 * w + s) * 128 : (MODE == 1 ? h * 128 : h * 256);
#pragma unroll
            for (int dt = 0; dt < NDT; ++dt) gwv[s][dt] = *(const u32x2*)(P.gate + row * P.gs + hcol + dt * 16 + 4 * g); }
        static_assert(NSUB * NDT == 16, "gate batch");
        asm volatile("" : "+v"(gwv[0][0]), "+v"(gwv[0][1]), "+v"(gwv[0][2]), "+v"(gwv[0][3]), "+v"(gwv[0][4]), "+v"(gwv[0][5]), "+v"(gwv[0][6]), "+v"(gwv[0][7]),
                          "+v"(gwv[NSUB - 1][NDT - 8]), "+v"(gwv[NSUB - 1][NDT - 7]), "+v"(gwv[NSUB - 1][NDT - 6]), "+v"(gwv[NSUB - 1][NDT - 5]), "+v"(gwv[NSUB - 1][NDT - 4]), "+v"(gwv[NSUB - 1][NDT - 3]), "+v"(gwv[NSUB - 1][NDT - 2]), "+v"(gwv[NSUB - 1][NDT - 1]));
#pragma unroll
        for (int s = 0; s < NSUB; ++s) {
            const size_t row = row0 + tqs[s];
            float inv = 1.f, mean = 0.f;
            if (MODE != 2) inv = 1.0f / ol[s][0];
            else { float s1 = 0.f;
#pragma unroll
                for (int dt = 0; dt < NDT; ++dt) s1 += (o[s][dt][0] + o[s][dt][1]) + (o[s][dt][2] + o[s][dt][3]);
                s1 = xsum32(xsum16(s1)); mean = s1 * (1.0f / 256.0f); float s2 = 0.f;
#pragma unroll
                for (int dt = 0; dt < NDT; ++dt)
#pragma unroll
                    for (int e = 0; e < 4; ++e) { const float d = o[s][dt][e] - mean; s2 += d * d; }
                s2 = xsum32(xsum16(s2)); inv = rsqrtf(s2 * (1.0f / 256.0f) + NORM_EPS); }
            const int hcol = (MODE == 0) ? (2 * w + s) * 128 : (MODE == 1 ? h * 128 : h * 256);
#pragma unroll
            for (int dt = 0; dt < NDT; ++dt) { const int col = hcol + dt * 16 + 4 * g;
                const u32x2 gw = gwv[s][dt];
                float y[4];
#pragma unroll
                for (int e = 0; e < 4; ++e) { const float gv = (e & 1) ? bfhi(gw[e >> 1]) : bflo(gw[e >> 1]); float v = (o[s][dt][e] - mean) * inv; if (MODE == 2) v *= P.gn[col + e]; y[e] = v * fsilu(gv); }
                *(unsigned*)(P.mix + row * DM + col) = pg8::cvt_pk4_fp8(y[0] * MIX8_SCALE, y[1] * MIX8_SCALE, y[2] * MIX8_SCALE, y[3] * MIX8_SCALE); }
        }
    }
}

constexpr int RC_Q = 0, RC_K = 32768, RC_V = 65536, RC_ST = 81920, RC_STP = 528;
static_assert(RC_ST + 64 * RC_STP <= RING_BYTES, "retention LDS");
__device__ __forceinline__ void retention_chunk_phase(Frame& F, const bf16* Z, bf16* RAW) {
    OPAQUE_TID();
    const int tid = F.tid, l = F.lane, w = F.wave, li = l & 15, g = l >> 4;
    LAS unsigned char* lds = F.lds;
    for (int u = F.vc; u < 256; u += F.G) {
        const int b = u >> 5, h = (u >> 2) & 7, es = u & 3;
        const float lg = log2f(1.0f - exp2f(-5.0f - (float)h));
        const bf16* qsrc = Z + (size_t)b * SEQ * LDZE + ZE_QB + h * 256;
        const bf16* ksrc = Z + (size_t)b * SEQ * LDZE + ZE_KB + h * 256;
        const bf16* vsrc = Z + (size_t)b * SEQ * LDZE + ZE_VB + h * 256 + es * 64;
        const int mrow = (tid & 255) >> 1;
        const unsigned goff0 = (unsigned)(mrow * LDZE + (tid >> 8) * 16 + (tid & 1) * 8);
        { u32x4 z4 = {0u, 0u, 0u, 0u}; asm volatile("" : "+v"(z4));
          for (int i = tid; i < 64 * RC_STP / 16; i += NT) *(LAS u32x4*)(lds + RC_ST + i * 16) = z4; }
        f32x4 S[2][4];
#pragma unroll
        for (int hf = 0; hf < 2; ++hf)
#pragma unroll
            for (int et = 0; et < 4; ++et) S[hf][et] = (f32x4){0.f, 0.f, 0.f, 0.f};
        const float g128 = __builtin_amdgcn_exp2f(128.0f * lg);
        u32x4 qreg[4], kreg[4], vreg[2];
#define RC_LOAD_QK(ck_, hf_) do { const bf16* q_ = qsrc + (size_t)(ck_) * 128 * LDZE + (hf_) * 128; const bf16* k_ = ksrc + (size_t)(ck_) * 128 * LDZE + (hf_) * 128; \
        _Pragma("unroll") for (int r = 0; r < 4; ++r) { qreg[r] = *(const u32x4*)(q_ + r * 32 + goff0); kreg[r] = *(const u32x4*)(k_ + r * 32 + goff0); } } while (0)
#define RC_LOAD_V(ck_) do { const bf16* v_ = vsrc + (size_t)(ck_) * 128 * LDZE; _Pragma("unroll") for (int r = 0; r < 2; ++r) vreg[r] = *(const u32x4*)(v_ + r * 32 + goff0); } while (0)
#define RC_STORE_QK() do { const float km_ = __builtin_amdgcn_exp2f(-(float)mrow * lg); _Pragma("unroll") for (int r = 0; r < 4; ++r) { *(LAS u32x4*)(lds + RC_Q + r * 8192 + tid * 16) = qreg[r]; u32x4 kw_;   \
        _Pragma("unroll") for (int e_ = 0; e_ < 4; ++e_) kw_[e_] = pk2(bflo(kreg[r][e_]) * km_, bfhi(kreg[r][e_]) * km_); \
        *(LAS u32x4*)(lds + RC_K + r * 8192 + tid * 16) = kw_; } } while (0)
#define RC_STORE_V() do { _Pragma("unroll") for (int r = 0; r < 2; ++r) *(LAS u32x4*)(lds + RC_V + r * 8192 + tid * 16) = vreg[r]; } while (0)
        RC_LOAD_QK(0, 0); RC_LOAD_V(0);
#pragma unroll 1
        for (int ck = 0; ck < 16; ++ck) {
            int go = g, lo_ = li; asm volatile("" : "+v"(go), "+v"(lo_));
            f32x4 st[8], cross[4];
#pragma unroll
            for (int mt = 0; mt < 8; ++mt) st[mt] = (f32x4){0.f, 0.f, 0.f, 0.f};
#pragma unroll
            for (int et = 0; et < 4; ++et) cross[et] = (f32x4){0.f, 0.f, 0.f, 0.f};
#pragma unroll
            for (int hf = 0; hf < 2; ++hf)
#pragma unroll
                for (int et = 0; et < 4; ++et) S[hf][et] = S[hf][et] * g128;
#pragma unroll
            for (int hf = 0; hf < 2; ++hf) {
                RC_STORE_QK(); if (hf == 0) RC_STORE_V();
                __syncthreads();
                if (hf == 0) RC_LOAD_QK(ck, 1); else if (ck + 1 < 16) { RC_LOAD_QK(ck + 1, 0); RC_LOAD_V(ck + 1); }
                auto rc_frag = [&](const int k) __attribute__((always_inline)) -> bf16x8 {
                    if (k < 36) { const int kk = k / 9, r = k % 9;
                        if (r == 0) return *(const LAS bf16x8*)(lds + RC_Q + (2 * kk + (g >> 1)) * 4096 + (16 * w + li) * 32 + (g & 1) * 16);
                        return *(const LAS bf16x8*)(lds + RC_K + (2 * kk + (g >> 1)) * 4096 + (16 * (r - 1) + li) * 32 + (g & 1) * 16); }
                    if (k < 56) { const int i = k - 36, kk = i / 5, r = i % 5;
                        if (r == 0) return *(const LAS bf16x8*)(lds + RC_Q + (2 * kk + (g >> 1)) * 4096 + (16 * w + li) * 32 + (g & 1) * 16);
                        return *(const LAS bf16x8*)(lds + RC_ST + (16 * (r - 1) + li) * RC_STP + (128 * hf + 32 * kk + 8 * g) * 2); }
                    const int i = k - 56, ms = i / 5, r = i % 5;
                    if (r == 0) { const LAS unsigned char* kp = lds + RC_K + w * 4096 + (32 * ms + 8 * g + (li >> 2)) * 32 + (li & 3) * 8; return cat8(tr_read(kp), tr_read(kp + 128)); }
                    const LAS unsigned char* vp = lds + RC_V + (r - 1) * 4096 + (32 * ms + 8 * g + (li >> 2)) * 32 + (li & 3) * 8; return cat8(tr_read(vp), tr_read(vp + 128)); };
                constexpr int RPD = 5, NST = 76;
                bf16x8 fr[RPD + 1];
#pragma unroll
                for (int k = 0; k < RPD; ++k) fr[k] = rc_frag(k);
                bf16x8 ocur = fr[0];
#pragma unroll
                for (int k = 0; k < NST; ++k) {
                    if (k + RPD < NST) fr[(k + RPD) % (RPD + 1)] = rc_frag(k + RPD);
                    const bf16x8 f = fr[k % (RPD + 1)];
                    if (k < 36) { if (k % 9 == 0) ocur = f; else st[k % 9 - 1] = MFMA16(f, ocur, st[k % 9 - 1]); }
                    else if (k < 56) { if ((k - 36) % 5 == 0) ocur = f; else cross[(k - 36) % 5 - 1] = MFMA16(ocur, f, cross[(k - 36) % 5 - 1]); }
                    else { if ((k - 56) % 5 == 0) ocur = f; else S[hf][(k - 56) % 5 - 1] = MFMA16(ocur, f, S[hf][(k - 56) % 5 - 1]); }
                    __builtin_amdgcn_sched_barrier(0); }
                __syncthreads();
            }
            const int n = 16 * w + lo_; const float cn = __builtin_amdgcn_exp2f((float)n * lg) * 0.0625f;
            f32x4 inner[4];
#pragma unroll
            for (int et = 0; et < 4; ++et) inner[et] = (f32x4){0.f, 0.f, 0.f, 0.f};
#pragma unroll
            for (int ms = 0; ms < 4; ++ms) {
                float p[8];
#pragma unroll
                for (int e = 0; e < 8; ++e) { const int m = 32 * ms + (e >> 2) * 16 + 4 * go + (e & 3); const float v = st[2 * ms + (e >> 2)][e & 3] * cn; p[e] = (m <= n) ? v : 0.f; }
                u32x4 pw; pw.x = pk2(p[0], p[1]); pw.y = pk2(p[2], p[3]); pw.z = pk2(p[4], p[5]); pw.w = pk2(p[6], p[7]);
                const bf16x8 pa = __builtin_bit_cast(bf16x8, pw);
#pragma unroll
                for (int et = 0; et < 4; ++et) { const LAS unsigned char* vp = lds + RC_V + et * 4096 + (32 * ms + 4 * g + (li >> 2)) * 32 + (li & 3) * 8;
                    const bf16x8 vb8 = cat8(tr_read(vp), tr_read(vp + 512)); inner[et] = MFMA16(pa, vb8, inner[et]); }
                __builtin_amdgcn_sched_barrier(0);
            }
            {
                bf16* orow = RAW + ((size_t)b * SEQ + ck * 128 + 16 * w + 4 * g) * 2048 + h * 256 + es * 64 + li;
#pragma unroll
                for (int r = 0; r < 4; ++r) { const float qd = __builtin_amdgcn_exp2f((float)(16 * w + 4 * go + r + 1 + 127) * lg) * 0.0625f;
#pragma unroll
                    for (int et = 0; et < 4; ++et) { const float o = inner[et][r] + qd * cross[et][r]; orow[(size_t)r * 2048 + et * 16] = (bf16)(pk2(o, 0.f) & 0xffffu); } }
            }
#pragma unroll
            for (int hf = 0; hf < 2; ++hf)
#pragma unroll
                for (int et = 0; et < 4; ++et) { u32x2 sw; sw.x = pk2(S[hf][et][0], S[hf][et][1]); sw.y = pk2(S[hf][et][2], S[hf][et][3]);
                    *(LAS u32x2*)(lds + RC_ST + (16 * et + li) * RC_STP + (128 * hf + 16 * w + 4 * g) * 2) = sw; }
            __syncthreads();
        }
#undef RC_LOAD_QK
#undef RC_LOAD_V
#undef RC_STORE_QK
#undef RC_STORE_V
    }
}
__device__ __forceinline__ void ret_finish_phase(Frame& F, const bf16* RAW, const bf16* Z, const float* gn, unsigned char* MIX) {
    OPAQUE_TID();
    const int gw = F.c * NWAVES + F.wave, NGW = F.G * NWAVES, l = F.lane;
    u32x4 cur[8], nxt[8];
#define RF_LOAD(dst, m_) do { _Pragma("unroll") for (int j = 0; j < 4; ++j) { dst[j] = ((const u32x4*)(RAW + (size_t)(m_) * 2048 + 32 * l))[j]; dst[4 + j] = ((const u32x4*)(Z + (size_t)(m_) * LDZE + ZE_GB + 32 * l))[j]; } } while (0)
    f32x4 gg8[8];
#pragma unroll
    for (int j = 0; j < 8; ++j) gg8[j] = ((const f32x4*)(gn + 32 * l))[j];
    if (gw < MROWS) RF_LOAD(cur, gw);
    for (int m = gw; m < MROWS; m += NGW) {
        if (m + NGW < MROWS) RF_LOAD(nxt, m + NGW);
        float v[32]; float s1 = 0.f;
#pragma unroll
        for (int j = 0; j < 4; ++j)
#pragma unroll
            for (int e = 0; e < 4; ++e) { v[8 * j + 2 * e] = bflo(cur[j][e]); v[8 * j + 2 * e + 1] = bfhi(cur[j][e]); }
#pragma unroll
        for (int e = 0; e < 32; ++e) s1 += v[e];
        s1 += shx(s1, 1, l); s1 += shx(s1, 2, l); s1 += shx(s1, 4, l);
        const float mean = s1 * (1.0f / 256.0f); float s2 = 0.f;
#pragma unroll
        for (int e = 0; e < 32; ++e) { const float d = v[e] - mean; s2 += d * d; }
        s2 += shx(s2, 1, l); s2 += shx(s2, 2, l); s2 += shx(s2, 4, l);
        const float rstd = rsqrtf(s2 * (1.0f / 256.0f) + NORM_EPS);
        unsigned* o = (unsigned*)(MIX + (size_t)m * DM + 2048 + 32 * l);
#pragma unroll
        for (int j = 0; j < 8; ++j) { const f32x4 gg = gg8[j]; float y[4];
#pragma unroll
            for (int e = 0; e < 4; ++e) { const unsigned gwd = cur[4 + (j >> 1)][(j & 1) * 2 + (e >> 1)]; const float gv = (e & 1) ? bfhi(gwd) : bflo(gwd); y[e] = (v[4 * j + e] - mean) * rstd * gg[e] * fsilu(gv) * MIX8_SCALE; }
            o[j] = pg8::cvt_pk4_fp8(y[0], y[1], y[2], y[3]); }
#pragma unroll
        for (int j = 0; j < 8; ++j) cur[j] = nxt[j];
    }
#undef RF_LOAD
}

__device__ __forceinline__ void gmlp_phase(Frame& F, const bf16* Z, const float* STATS, const bf16* CWS, const float* cbs, const float* vgain, unsigned char* MIX) {
    OPAQUE_TID();
    const int tid = F.tid, l = F.lane, w = F.wave, li = l & 15, gq = l >> 4;
    LAS unsigned char* Vl = F.lds;
    const int srow = (tid & 255) >> 1, c80 = (tid >> 8) * 2 + (tid & 1);
    u32x4 vcur[4], vnxt[4]; f32x2 scur, snxt;
#define GM_LOAD(dv, ds, u_) do { const int bc_ = (u_) >> 4, g_ = (u_) & 15; const bf16* zp_ = Z + ((size_t)bc_ * 128 + srow) * LDZO + ZO_CV + g_ * 128 + c80 * 8; \
        _Pragma("unroll") for (int r4 = 0; r4 < 4; ++r4) dv[r4] = *(const u32x4*)(zp_ + r4 * 32); ds = *(const f32x2*)(STATS + 2 * ((size_t)bc_ * 128 + srow)); } while (0)
    if (F.c < 2048) GM_LOAD(vcur, scur, F.c);
    for (int r = 0;; ++r) {
        const int u = r * F.G + F.c; if (u >= 2048) break;
        const int bc = u >> 4, g = u & 15; const size_t m0 = (size_t)bc * 128;
        const int t = 16 * w + li, kkmax = (16 * w + 15) >> 5; const size_t row = m0 + t;
        const bf16* wrow = CWS + ((size_t)g * 128 + t) * 128 + 8 * gq;
        bf16x8 bw[4];
#pragma unroll
        for (int kk = 0; kk < 4; ++kk) bw[kk] = *(const bf16x8*)(wrow + kk * 32);
        u32x2 cu[8], gc[8];
#pragma unroll
        for (int dt = 0; dt < 8; ++dt) { const int col = g * 128 + dt * 16 + 4 * gq; cu[dt] = *(const u32x2*)(Z + row * LDZO + ZO_CU + col); gc[dt] = *(const u32x2*)(Z + row * LDZO + ZO_GC + col); }
        const float bias = cbs[g * 128 + t];
        f32x4 vg[4][2];
#pragma unroll
        for (int r4 = 0; r4 < 4; ++r4) { const int c8 = c80 + 4 * r4; vg[r4][0] = *(const f32x4*)(vgain + g * 128 + c8 * 8); vg[r4][1] = *(const f32x4*)(vgain + g * 128 + c8 * 8 + 4); }
        asm volatile("" : "+v"(vg[0][0]), "+v"(vg[0][1]), "+v"(vg[1][0]), "+v"(vg[1][1]), "+v"(vg[2][0]), "+v"(vg[2][1]), "+v"(vg[3][0]), "+v"(vg[3][1]));
#pragma unroll
        for (int r4 = 0; r4 < 4; ++r4) {
            const f32x4 ga = vg[r4][0], gb = vg[r4][1];
            float y[8];
#pragma unroll
            for (int e = 0; e < 4; ++e) { y[2 * e] = (fgelu(bflo(vcur[r4][e])) - scur.x) * scur.y; y[2 * e + 1] = (fgelu(bfhi(vcur[r4][e])) - scur.x) * scur.y; }
            u32x4 ow; ow.x = pk2(y[0] * ga[0], y[1] * ga[1]); ow.y = pk2(y[2] * ga[2], y[3] * ga[3]); ow.z = pk2(y[4] * gb[0], y[5] * gb[1]); ow.w = pk2(y[6] * gb[2], y[7] * gb[3]);
            *(LAS u32x4*)(Vl + (tid + NT * r4) * 16) = ow; }
        __syncthreads();
        const int un = u + F.G;
        if (un < 2048) GM_LOAD(vnxt, snxt, un);
        f32x4 acc[8];
#pragma unroll
        for (int dt = 0; dt < 8; ++dt) acc[dt] = (f32x4){0.f, 0.f, 0.f, 0.f};
#pragma unroll
        for (int kk = 0; kk < 4; ++kk) if (kk <= kkmax) {
#pragma unroll
            for (int dt = 0; dt < 8; ++dt) { const LAS unsigned char* vp = Vl + dt * 4096 + (kk * 32 + 8 * gq + (li >> 2)) * 32 + (li & 3) * 8;
                const bf16x8 a = cat8(tr_read(vp), tr_read(vp + 128)); acc[dt] = MFMA16(a, bw[kk], acc[dt]); } }
#pragma unroll
        for (int dt = 0; dt < 8; ++dt) { const int col = g * 128 + dt * 16 + 4 * gq;
            float y[4];
#pragma unroll
            for (int e = 0; e < 4; ++e) { const float uv = (e & 1) ? bfhi(cu[dt][e >> 1]) : bflo(cu[dt][e >> 1]), gv = (e & 1) ? bfhi(gc[dt][e >> 1]) : bflo(gc[dt][e >> 1]); y[e] = fgelu(uv) * (acc[dt][e] + bias) * fsilu(gv); }
            *(unsigned*)(MIX + row * DM + col) = pg8::cvt_pk4_fp8(y[0] * MIX8_SCALE, y[1] * MIX8_SCALE, y[2] * MIX8_SCALE, y[3] * MIX8_SCALE); }
        __syncthreads();
#pragma unroll
        for (int r4 = 0; r4 < 4; ++r4) vcur[r4] = vnxt[r4];
        scur = snxt;
    }
#undef GM_LOAD
}

__device__ __forceinline__ void kr_phase(Frame& F, const unsigned char* H8, const unsigned char* W, const float* RSTD, bf16* Z) {
    OPAQUE_TID();
    const int l = F.lane, w = F.wave, fr = l & 15, fq = l >> 4;
    LAS f32x4* red = (LAS f32x4*)F.lds;
    for (int rb = F.c; rb < MROWS / 64; rb += F.G) {
        f32x4 acc[4][4];
#pragma unroll
        for (int m = 0; m < 4; ++m)
#pragma unroll
            for (int n = 0; n < 4; ++n) acc[m][n] = (f32x4){0.f, 0.f, 0.f, 0.f};
        const unsigned char* ap = H8 + (size_t)rb * 64 * DM;
        const unsigned char* bp = W;
        const unsigned lo = (unsigned)(fr * DM + w * 512 + fq * 32);
        pg8::i32x8 fa[2][4], fb[4];
#define KR_LOADA(s_, ks_) do { _Pragma("unroll") for (int m = 0; m < 4; ++m) { const unsigned char* p = ap + (lo + (unsigned)(m * 16 * DM + (ks_) * 128)); fa[s_][m] = pg8::cat_f8(*(const bf16x8*)p, *(const bf16x8*)(p + 16)); } } while (0)
#define KR_LOADB(ks_) do { _Pragma("unroll") for (int n = 0; n < 4; ++n) { const unsigned char* p = bp + (lo + (unsigned)(n * 16 * DM + (ks_) * 128)); fb[n] = pg8::cat_f8(*(const bf16x8*)p, *(const bf16x8*)(p + 16)); } } while (0)
        KR_LOADA(0, 0); KR_LOADB(0); KR_LOADA(1, 1);
#pragma unroll
        for (int ks = 0; ks < 4; ++ks) {
#pragma unroll
            for (int m = 0; m < 4; ++m)
#pragma unroll
                for (int n = 0; n < 4; ++n) asm volatile("v_mfma_f32_16x16x128_f8f6f4 %0, %1, %2, %0" : "+v"(acc[m][n]) : "v"(fb[n]), "v"(fa[ks & 1][m]));
            if (ks + 1 < 4) { asm volatile("s_nop 7" ::: "memory"); KR_LOADB(ks + 1); if (ks + 2 < 4) KR_LOADA(ks & 1, ks + 2); } }
#undef KR_LOADA
#undef KR_LOADB
        asm volatile("s_nop 15\n\ts_nop 15" ::: "memory");
#pragma unroll
        for (int m = 0; m < 4; ++m)
#pragma unroll
            for (int n = 0; n < 4; ++n) { asm volatile("" : "+v"(acc[m][n])); red[(w * 16 + m * 4 + n) * 64 + l] = acc[m][n]; }
        __syncthreads();
#pragma unroll
        for (int r2 = 0; r2 < 2; ++r2) { const int e = F.tid + 512 * r2, tile = e >> 6, ll = e & 63; f32x4 s = red[tile * 64 + ll];
#pragma unroll
            for (int ww = 1; ww < 8; ++ww) s = s + red[(ww * 16 + tile) * 64 + ll];
            const int row = rb * 64 + (tile >> 2) * 16 + (ll & 15), col = (tile & 3) * 16 + 4 * (ll >> 4); const float sc = RSTD[row] * (1.0f / W8_SCALE);
            u32x2 o; o.x = pk2(s[0] * sc, s[1] * sc); o.y = pk2(s[2] * sc, s[3] * sc); *(u32x2*)(Z + (size_t)row * LDZO + ZO_KR + col) = o; }
        __syncthreads();
    }
}

constexpr int NSTEPS = 1 + 2 * 6 + 2 * 8 - 1;
__global__ void __launch_bounds__(NT, 2) mk_fwd(Args A) {
    extern __shared__ __attribute__((aligned(16))) unsigned char lds_raw[];
    Frame F;
    F.lds = (LAS unsigned char*)lds_raw;
    F.tid = threadIdx.x; F.lane = F.tid & 63; F.wave = __builtin_amdgcn_readfirstlane(F.tid >> 6); F.w0 = F.wave; F.G = gridDim.x; F.c = blockIdx.x; F.ws = A.ws;
    volatile LAS unsigned* MISC = (volatile LAS unsigned*)(F.lds + MISC_OFF);
    if (F.tid < 64) MISC[F.tid] = 0u;
    __syncthreads();
    unsigned* ctl = (unsigned*)(A.ws + WS_CTL);
    XcdBarrier bar; bar.bar = ctl + CW_BAR; bar.x = 0; bar.st = MISC + 8;
    if (A.hi - A.lo > 1) bar = xcd_barrier_post(ctl + CW_BAR, MISC + 8);
    bar.w0 = F.w0;
    const float* x_in = (const float*)A.in[0];
    float* out = A.out;
    int step = 0;
#ifndef PHM
#define PHM 0xFFFFFF
#endif
#ifndef DBL
#define DBL 0
#endif
#define PHS(k, ...) { if constexpr (((PHM) >> (k)) & 1) { __VA_ARGS__ } if constexpr (((DBL) >> (k)) & 1) { __syncthreads(); __VA_ARGS__ } }
#define RUN(...) do { if (step >= A.lo && step < A.hi) { __VA_ARGS__ } if (step >= A.lo && step + 1 < A.hi) xcd_barrier_t<false>(bar); ++step; } while (0)
#define RUN_FIRST(...) do { if (step >= A.lo && step < A.hi) { __VA_ARGS__ } if (step >= A.lo && step + 1 < A.hi) xcd_barrier_t<true>(bar); ++step; } while (0)

    RUN_FIRST( PHS(0, prologue_phase(F, A);)
               PHS(1, rmsnorm_phase(F, x_in, (const float*)nullptr, (float*)(A.ws + WS_RSTD), (bf16*)(A.ws + WS_H), A.ws + WS_H8);) );
#pragma unroll 1
    for (int layer = 0; layer < DEPTH; ++layer) {
        const int j = layer >> 1; const bool odd = (layer & 1) != 0;
        size_t wz = 0; asm volatile("" : "+s"(wz)); unsigned char* ws = A.ws + wz;
        bf16* H = (bf16*)(ws + WS_H); unsigned char* H8 = ws + WS_H8; unsigned char* X18 = ws + WS_X18; float* PS = (float*)(ws + WS_PS); float* RSTD = (float*)(ws + WS_RSTD); bf16* XB = (bf16*)(ws + WS_XB); bf16* Z = (bf16*)(ws + WS_Z); unsigned char* MIX = ws + WS_MIX;     bf16* PE = (bf16*)(ws + WS_PE);
        if (layer > 0) RUN( PHS(1, rmsnorm_phase(F, (const float*)nullptr, PS, RSTD, H, H8);) );
        RUN( PHS(2, { const int N = odd ? ZO_KR : ZE_N8, ldz = odd ? LDZO : LDZE; const unsigned char* W = odd ? (ws + WS_WINO + (size_t)j * 41 * MiB) : (ws + WS_WINE8 + (size_t)j * 48 * MiB);
               pg8::Gemm gm{H8, W, MROWS, N, DM, DM}; pg8::SkewOrder S; S.init2(MROWS, N, F.G, F.c); if (odd) S.nfull = -1; pg8::EpiBf16 E{Z, ldz, 1.0f / W8_SCALE, RSTD};
               pg8::gemm_phase<pg8::EpiBf16, pg8::SkewOrder, true, true, true>(F.lds, gm, S, E, F.w0); })
             if (odd) PHS(2, kr_phase(F, H8, ws + WS_WINO + (size_t)j * 41 * MiB + (size_t)ZO_KR * DM, RSTD, Z);)
             if (!odd) PHS(2, { pg8::Gemm gm{layer == 0 ? H : XB, ws + WS_WINE16 + (size_t)j * 20 * MiB, MROWS, ZE_N16, DM * 2, DM * 2};     pg8::StaticOrder S; S.init(MROWS, ZE_N16, F.G, F.c); pg8::EpiBf16 E{Z + ZE_N8, LDZE, 1.0f, RSTD};
               pg8::gemm_phase<pg8::EpiBf16, pg8::StaticOrder, true, true>(F.lds, gm, S, E, F.w0); }) );
        if (!odd) {
            RUN( PHS(3, prep_even_phase(F, Z, (const float*)A.in[6] + j * 128);)
                 PHS(4, indexer_phase(F, Z, (unsigned*)(ws + WS_MASK), (float*)(ws + WS_SCR));)
                 PHS(5, retention_chunk_phase(F, Z, (bf16*)(ws + WS_RAW));) );
            RUN( PHS(16, ret_finish_phase(F, (const bf16*)(ws + WS_RAW), Z, (const float*)A.in[7] + j * 2048, MIX);)
                 PHS(6, { AttnP P{Z + ZE_QA, LDZE, Z + ZE_KA, LDZE, Z + ZE_VA, LDZE, Z + ZE_GA, LDZE, MIX, (const int*)A.in[2], (const unsigned*)(ws + WS_MASK), (const float*)A.in[5] + j * 128, (const float*)A.in[6] + j * 128}; attn_phase<0>(F, P); }) );
        } else {
            unsigned char* CQN = ws + WS_CQN; unsigned char* CKVN = ws + WS_CKVN;     bf16* QF = (bf16*)(ws + WS_QF); bf16* KVF = (bf16*)(ws + WS_KVF); bf16* KM = (bf16*)(ws + WS_KM);
            RUN( PHS(7, prep_odd1_phase(F, Z, (const float*)A.in[13] + j * 1536, (const float*)A.in[14] + j * 512, CQN, CKVN, (float*)(ws + WS_STATS));) );
            RUN( PHS(8, { pg8::Gemm gm{CQN, ws + WS_WUQ + (size_t)j * 9 * MiB, MROWS, 3072, 1536, 1536}; pg8::StaticOrder S; S.init(MROWS, 3072, F.G, F.c); pg8::EpiBf16 E{QF, 3072, 1.0f / (W8_SCALE * A8_SCALE), nullptr};
                   pg8::gemm_phase<pg8::EpiBf16, pg8::StaticOrder, true, true, true>(F.lds, gm, S, E, F.w0); })
                 PHS(9, { pg8::Gemm gm{CKVN, ws + WS_WUKV + (size_t)j * 4 * MiB, MROWS, 4096, 512, 512}; pg8::StaticOrder S; S.init(MROWS, 4096, F.G, F.c); pg8::EpiBf16 E{KVF, 4096, 1.0f / (W8_SCALE * A8_SCALE), nullptr};
                   pg8::gemm_phase<pg8::EpiBf16, pg8::StaticOrder, true, true, true>(F.lds, gm, S, E, F.w0); }) );
            RUN( PHS(10, prep_odd2_phase(F, QF, KVF, Z, KM, (const int*)A.in[2], (const float*)A.in[17] + j * 192, (const float*)A.in[18] + j * 192);)
                 PHS(11, gmlp_phase(F, Z, (const float*)(ws + WS_STATS), (const bf16*)(ws + WS_CWS) + (size_t)j * 16 * 128 * 128, (const float*)A.in[12] + j * 2048, (const float*)A.in[10] + j * 2048, MIX);) );
            RUN( PHS(12, { AttnP P{QF, 3072, KM, 192, KVF + 128, 4096, Z + ZO_GD, LDZO, MIX + 2048, (const int*)A.in[2], nullptr, (const float*)A.in[17] + j * 192, (const float*)A.in[18] + j * 192}; attn_phase<1>(F, P); }) );
        }
        RUN( PHS(13, { pg8::Gemm gm{MIX, ws + WS_WOUT + (size_t)layer * 16 * MiB, MROWS, DM, DM, DM}; pg8::StaticOrder S; S.init(MROWS, DM, F.G, F.c);
               pg8::EpiResid E{layer == 0 ? H : XB, XB, X18, DM, 1.0f / (W8_SCALE * MIX8_SCALE)};
               pg8::gemm_phase<pg8::EpiResid, pg8::StaticOrder, true, true, true>(F.lds, gm, S, E, F.w0); })
             PHS(14, { int kple = PLE; asm volatile("" : "+s"(kple)); pg8::Gemm gm{ws + WS_PB + (size_t)layer * MROWS * PLE, ws + WS_WPLE + (size_t)layer * 2 * MiB, MROWS, DM, kple, kple}; pg8::StaticOrder S; S.init(MROWS, DM, F.G, F.c);
               pg8::EpiBf16 E{PE, DM, 1.0f / (W8_SCALE * A8_SCALE), nullptr};
               pg8::gemm_phase<pg8::EpiBf16, pg8::StaticOrder, true, true, true>(F.lds, gm, S, E, F.w0); }) );
        RUN( PHS(15, { pg8::Gemm gm{X18, ws + WS_WGATE + (size_t)layer * 16 * MiB, MROWS, DM, DM, DM};   pg8::StaticOrder S; S.init(MROWS, DM, F.G, F.c);
               pg8::EpiGate E{XB, PE, layer == DEPTH - 1 ? out : (float*)nullptr, H8, PS, DM, 1.0f / W8_SCALE};
               pg8::gemm_phase<pg8::EpiGate, pg8::StaticOrder, true, true, true>(F.lds, gm, S, E, F.w0); }) );
    }
#undef RUN
#undef RUN_FIRST
}

extern "C" void kernel_launch(void* const* d_in, const int* in_sizes, int n_in, void* d_out, int out_size, void* d_ws, size_t ws_size, hipStream_t stream) {
    static int grid = 0;
    if (grid == 0) {
        if (n_in != 22 || in_sizes[0] != MROWS * DM || out_size != MROWS * DM || ws_size < WS_END) {
            fprintf(stderr, "kernel_launch: unexpected problem (n_in %d, in0 %d, out %d, ws %zu < %zu); nothing launched\n", n_in, n_in > 0 ? in_sizes[0] : -1, out_size, ws_size, (size_t)WS_END); grid = -1; return; }
        int dev = 0, cus = 0, per_cu = 0;
        if (hipGetDevice(&dev) != hipSuccess || hipDeviceGetAttribute(&cus, hipDeviceAttributeMultiprocessorCount, dev) != hipSuccess) { grid = -1; return; }
        if (hipFuncSetAttribute((const void*)mk_fwd, hipFuncAttributeMaxDynamicSharedMemorySize, LDS_BYTES) != hipSuccess) { fprintf(stderr, "kernel_launch: hipFuncSetAttribute failed\n"); grid = -1; return; }
        if (hipOccupancyMaxActiveBlocksPerMultiprocessor(&per_cu, (const void*)mk_fwd, NT, LDS_BYTES) != hipSuccess || per_cu < 1) fprintf(stderr, "kernel_launch: occupancy query says %d blocks per CU\n", per_cu);
        (void)hipGetLastError();
        grid = cus < 256 ? cus : 256;
    }
    if (grid < 0) return;
    if (hipMemsetAsync((char*)d_ws + WS_CTL, 0, CTL_ZERO_BYTES, stream) != hipSuccess) return;
    Args a{};
    for (int i = 0; i < 22; ++i) a.in[i] = d_in[i];
    a.out = (float*)d_out; a.ws = (unsigned char*)d_ws;
#if MK_MULTI
    for (int s = 0; s < NSTEPS; ++s) { a.lo = s; a.hi = s + 1; hipLaunchKernelGGL(mk_fwd, dim3(grid), dim3(NT), LDS_BYTES, stream, a); }
#else
    a.lo = 0; a.hi = NSTEPS; hipLaunchKernelGGL(mk_fwd, dim3(grid), dim3(NT), LDS_BYTES, stream, a);
#endif
    const hipError_t le = hipPeekAtLastError();
    if (le != hipSuccess) fprintf(stderr, "kernel_launch: launch failed: %s\n", hipGetErrorName(le));
}
```
